# Optimizing an MI355X kernel written in HIP

```python
import math
import jax
import jax.numpy as jnp
from jax import lax
import numpy as np

D_MODEL = 4096
BATCH = 1
SEQ = 8192
DEPTH = 1

S5_WIDTH = D_MODEL
S5_GROUP = 16
S5_GROUPS = S5_WIDTH // S5_GROUP
S5_STATE = 64
S5_CHUNK = 128

M2_EXPAND = 2
M2_D_INNER = M2_EXPAND * D_MODEL
M2_HEADDIM = 64
M2_HEADS = M2_D_INNER // M2_HEADDIM
M2_GROUPS = 8
M2_HPG = M2_HEADS // M2_GROUPS
M2_STATE = 128
M2_CONV = 4
M2_CHUNK = 128
M2_CONV_DIM = M2_D_INNER + 2 * M2_GROUPS * M2_STATE

N_BRANCHES = 2
IN_COLS = 2 * S5_WIDTH + M2_D_INNER + M2_CONV_DIM + M2_HEADS + N_BRANCHES * D_MODEL
EPS = 1e-6

kernel_name = "hybrid_s5_ssd_gated_block"


def rms_norm(x, g):
    xf = x.astype(jnp.float32)
    xf = xf * lax.rsqrt(jnp.mean(xf * xf, axis=-1, keepdims=True) + EPS)
    return xf.astype(x.dtype) * g


def s5_combine(e1, e2):
    a1r, a1i, b1r, b1i = e1
    a2r, a2i, b2r, b2i = e2
    return (a2r * a1r - a2i * a1i, a2r * a1i + a2i * a1r,
            a2r * b1r - a2i * b1i + b2r, a2r * b1i + a2i * b1r + b2i)


def s5_mixer(u, lam_re, lam_im, log_step, b_re, b_im, c_re, c_im, d_skip):
    f32 = jnp.float32
    bsz, seqlen, _ = u.shape
    step = jnp.exp(log_step.astype(f32))[:, None]
    lre, lim = lam_re.astype(f32), lam_im.astype(f32)
    mag = jnp.exp(lre * step)
    lb_re, lb_im = mag * jnp.cos(lim * step), mag * jnp.sin(lim * step)
    den = lre * lre + lim * lim
    nr, ni = lb_re - 1.0, lb_im
    coef_re = (nr * lre + ni * lim) / den
    coef_im = (ni * lre - nr * lim) / den
    bre, bim = b_re.astype(f32), b_im.astype(f32)
    bb_re = coef_re[..., None] * bre - coef_im[..., None] * bim
    bb_im = coef_re[..., None] * bim + coef_im[..., None] * bre
    cre, cim = c_re.astype(f32), c_im.astype(f32)
    a_re = jnp.broadcast_to(lb_re, (bsz, S5_CHUNK, S5_GROUPS, S5_STATE))
    a_im = jnp.broadcast_to(lb_im, (bsz, S5_CHUNK, S5_GROUPS, S5_STATE))

    n_chunks = seqlen // S5_CHUNK
    uf = u.astype(f32)
    uc = uf.reshape(bsz, n_chunks, S5_CHUNK, S5_GROUPS, S5_GROUP).swapaxes(0, 1)

    def chunk_step(carry, u_chunk):
        h_re, h_im = carry
        bu_re = jnp.einsum('btgp,gnp->btgn', u_chunk, bb_re)
        bu_im = jnp.einsum('btgp,gnp->btgn', u_chunk, bb_im)
        bu_re = bu_re.at[:, 0].add(lb_re * h_re - lb_im * h_im)
        bu_im = bu_im.at[:, 0].add(lb_re * h_im + lb_im * h_re)
        _, _, s_re, s_im = lax.associative_scan(s5_combine, (a_re, a_im, bu_re, bu_im), axis=1)
        y = jnp.einsum('btgn,gpn->btgp', s_re, cre) - jnp.einsum('btgn,gpn->btgp', s_im, cim)
        return (s_re[:, -1], s_im[:, -1]), y

    h0 = jnp.zeros((bsz, S5_GROUPS, S5_STATE), f32)
    _, y = lax.scan(chunk_step, (h0, h0), uc)
    y = y.swapaxes(0, 1).reshape(bsz, seqlen, S5_WIDTH)
    return (y + d_skip.astype(f32) * uf).astype(u.dtype)


def causal_depthwise_conv(x, w, b):
    k_width, seqlen = w.shape[0], x.shape[1]
    xp = jnp.pad(x, ((0, 0), (k_width - 1, 0), (0, 0)))
    y = b
    for k in range(k_width):
        y = y + xp[:, k:k + seqlen] * w[k]
    return y


def ssd_chunked(xs, dt, a, bmat, cmat):
    f32 = jnp.float32
    bsz, seqlen = xs.shape[:2]
    nc = seqlen // M2_CHUNK

    def to_chunks(t):
        return t.reshape(bsz, nc, M2_CHUNK, *t.shape[2:]).swapaxes(0, 1)

    x5 = xs.astype(f32).reshape(bsz, seqlen, M2_GROUPS, M2_HPG, M2_HEADDIM)
    dt4 = dt.astype(f32).reshape(bsz, seqlen, M2_GROUPS, M2_HPG)
    a2 = a.astype(f32).reshape(M2_GROUPS, M2_HPG)
    causal = jnp.tril(jnp.ones((M2_CHUNK, M2_CHUNK), dtype=bool))[None, :, :, None, None]

    def chunk_step(state, inp):
        xc, dtc, bc, cc = inp
        acum = jnp.cumsum(dtc * a2, axis=1)
        seg = acum[:, :, None] - acum[:, None, :]
        decay = jnp.exp(jnp.where(causal, seg, -jnp.inf))
        xdt = xc * dtc[..., None]
        scores = jnp.einsum('btgn,bsgn->btsg', cc, bc)
        y_diag = jnp.einsum('btsgr,bsgrp->btgrp', scores[..., None] * decay, xdt)
        y_off = jnp.einsum('btgn,bgrpn->btgrp', cc, state) * jnp.exp(acum)[..., None]
        to_end = jnp.exp(acum[:, -1:] - acum)
        new_state = state * jnp.exp(acum[:, -1])[..., None, None] + jnp.einsum(
            'btgn,btgrp->bgrpn', bc, xdt * to_end[..., None])
        return new_state, y_diag + y_off

    init = jnp.zeros((bsz, M2_GROUPS, M2_HPG, M2_HEADDIM, M2_STATE), f32)
    _, y = lax.scan(chunk_step, init,
                    (to_chunks(x5), to_chunks(dt4), to_chunks(bmat.astype(f32)), to_chunks(cmat.astype(f32))))
    return y.swapaxes(0, 1).reshape(bsz, seqlen, M2_HEADS, M2_HEADDIM)


def mamba2_mixer(z, xbc, dt_raw, conv_w, conv_b, dt_bias, a_log, d_skip, norm_g):
    f32 = jnp.float32
    bsz, seqlen, _ = z.shape
    xbc = jax.nn.silu(causal_depthwise_conv(xbc, conv_w, conv_b))
    gn = M2_GROUPS * M2_STATE
    xs, bmat, cmat = jnp.split(xbc, [M2_D_INNER, M2_D_INNER + gn], axis=-1)
    xs = xs.reshape(bsz, seqlen, M2_HEADS, M2_HEADDIM)
    bmat = bmat.reshape(bsz, seqlen, M2_GROUPS, M2_STATE)
    cmat = cmat.reshape(bsz, seqlen, M2_GROUPS, M2_STATE)
    dt = jax.nn.softplus(dt_raw.astype(f32) + dt_bias.astype(f32))
    a = -jnp.exp(a_log.astype(f32))
    y = ssd_chunked(xs, dt, a, bmat, cmat)
    y = y + d_skip.astype(f32)[:, None] * xs.astype(f32)
    y = y.reshape(bsz, seqlen, M2_D_INNER) * jax.nn.silu(z.astype(f32))
    yg = y.reshape(bsz, seqlen, M2_GROUPS, M2_D_INNER // M2_GROUPS)
    yg = yg * lax.rsqrt(jnp.mean(yg * yg, axis=-1, keepdims=True) + EPS)
    return yg.reshape(bsz, seqlen, M2_D_INNER).astype(z.dtype) * norm_g


def setup_inputs(seed: int = 0) -> dict:
    key = jax.random.key(seed)
    ks = jax.random.split(key, 28)
    f32 = jnp.float32
    L = DEPTH

    def nrm(k, shape, scale):
        return scale * jax.random.normal(k, shape, f32)

    n_idx = jnp.arange(S5_STATE, dtype=f32)
    lam_re = -0.5 + nrm(ks[6], (L, S5_GROUPS, S5_STATE), 0.01)
    lam_im = math.pi * n_idx + nrm(ks[7], (L, S5_GROUPS, S5_STATE), 0.01)
    log_step = jax.random.uniform(ks[8], (L, S5_GROUPS), f32, math.log(1e-3), math.log(1e-1))
    dt0 = jnp.exp(jax.random.uniform(ks[17], (L, M2_HEADS), f32, math.log(1e-3), math.log(1e-1)))
    dt_bias = dt0 + jnp.log(-jnp.expm1(-dt0))
    a_log = jnp.log(jax.random.uniform(ks[18], (L, M2_HEADS), f32, 1.0, 16.0))
    return {
        'x': nrm(ks[0], (BATCH, SEQ, D_MODEL), 1.0),
        'c': nrm(ks[1], (BATCH, D_MODEL), 1.0),
        'w_ada': nrm(ks[2], (L, D_MODEL, 3 * D_MODEL), 0.5 * D_MODEL ** -0.5),
        'b_ada': nrm(ks[3], (L, 3 * D_MODEL), 0.01),
        'norm_g': 1.0 + nrm(ks[4], (L, D_MODEL), 0.01),
        'w_in': nrm(ks[5], (L, D_MODEL, IN_COLS), D_MODEL ** -0.5),
        's5_lambda_re': lam_re,
        's5_lambda_im': lam_im,
        's5_log_step': log_step,
        's5_b_re': nrm(ks[9], (L, S5_GROUPS, S5_STATE, S5_GROUP), (2 * S5_GROUP) ** -0.5),
        's5_b_im': nrm(ks[10], (L, S5_GROUPS, S5_STATE, S5_GROUP), (2 * S5_GROUP) ** -0.5),
        's5_c_re': nrm(ks[11], (L, S5_GROUPS, S5_GROUP, S5_STATE), S5_STATE ** -0.5),
        's5_c_im': nrm(ks[12], (L, S5_GROUPS, S5_GROUP, S5_STATE), S5_STATE ** -0.5),
        's5_d': nrm(ks[13], (L, S5_WIDTH), 1.0),
        's5_w_glu': nrm(ks[14], (L, S5_WIDTH, 2 * S5_WIDTH), S5_WIDTH ** -0.5),
        's5_b_glu': nrm(ks[15], (L, 2 * S5_WIDTH), 0.01),
        'm2_conv_w': nrm(ks[16], (L, M2_CONV, M2_CONV_DIM), M2_CONV ** -0.5),
        'm2_conv_b': nrm(ks[19], (L, M2_CONV_DIM), 0.01),
        'm2_dt_bias': dt_bias,
        'm2_a_log': a_log,
        'm2_d': 1.0 + nrm(ks[20], (L, M2_HEADS), 0.1),
        'm2_norm_g': 1.0 + nrm(ks[21], (L, M2_D_INNER), 0.01),
        'w_br_s5': nrm(ks[22], (L, S5_WIDTH, D_MODEL), S5_WIDTH ** -0.5),
        'w_br_m2': nrm(ks[23], (L, M2_D_INNER, D_MODEL), M2_D_INNER ** -0.5),
        'w_out': nrm(ks[24], (L, D_MODEL, D_MODEL), D_MODEL ** -0.5),
        'final_g': 1.0 + nrm(ks[25], (D_MODEL,), 0.01),
    }


def reference(x, c, w_ada, b_ada, norm_g, w_in, s5_lambda_re, s5_lambda_im, s5_log_step,
              s5_b_re, s5_b_im, s5_c_re, s5_c_im, s5_d, s5_w_glu, s5_b_glu,
              m2_conv_w, m2_conv_b, m2_dt_bias, m2_a_log, m2_d, m2_norm_g,
              w_br_s5, w_br_m2, w_out, final_g):
    widths = [S5_WIDTH, S5_WIDTH, M2_D_INNER, M2_CONV_DIM, M2_HEADS, D_MODEL]
    offsets = [int(o) for o in np.cumsum(widths)]
    for layer in range(DEPTH):
        mod = c @ w_ada[layer] + b_ada[layer]
        shift, scale, gate = jnp.split(mod, 3, axis=-1)
        h = rms_norm(x, norm_g[layer]) * (1.0 + scale[:, None]) + shift[:, None]
        proj = h @ w_in[layer]
        s5_u, s5_z, m2_z, m2_xbc, m2_dt, g_s5, g_m2 = jnp.split(proj, offsets, axis=-1)
        y_s5 = s5_mixer(s5_u, s5_lambda_re[layer], s5_lambda_im[layer], s5_log_step[layer],
                        s5_b_re[layer], s5_b_im[layer], s5_c_re[layer], s5_c_im[layer], s5_d[layer])
        glu = jax.nn.gelu(y_s5) @ s5_w_glu[layer] + s5_b_glu[layer]
        glu_a, glu_b = jnp.split(glu, 2, axis=-1)
        y_s5 = glu_a * jax.nn.sigmoid(glu_b) * jax.nn.silu(s5_z)
        y_m2 = mamba2_mixer(m2_z, m2_xbc, m2_dt, m2_conv_w[layer], m2_conv_b[layer],
                            m2_dt_bias[layer], m2_a_log[layer], m2_d[layer], m2_norm_g[layer])
        merged = (jax.nn.sigmoid(g_s5) * (y_s5 @ w_br_s5[layer])
                  + jax.nn.sigmoid(g_m2) * (y_m2 @ w_br_m2[layer]))
        x = x + gate[:, None] * (merged @ w_out[layer])
    return rms_norm(x, final_g)
```

```cpp
#include <hip/hip_runtime.h>
#include <cstdio>
#include <cstdint>
namespace pg8 {
#define PG8_LAS __attribute__((address_space(3)))
typedef unsigned short bf16_t;
typedef short bf16x8 __attribute__((ext_vector_type(8)));
typedef float f32x4 __attribute__((ext_vector_type(4)));
typedef unsigned u32x4 __attribute__((ext_vector_type(4)));
constexpr int BM = 256, BK = 64, HALF = 128, HTB = HALF * BK * 2  , STAGE_BYTES = 8 * HTB, NXCD = 8, WGM = 4;

__host__ __device__ __forceinline__ int lds_byte(int r, int c) { const int st = (r >> 4) * 2 + (c >> 5), rr = r & 15, cc = c & 31, ob = rr * 64 + cc * 2; return st * 1024 + (ob ^ (((ob >> 9) & 1) << 5)); }
__host__ __device__ __forceinline__ void stage_rc(int b, int& R, int& C) { const int st = b / 1024, sb = b % 1024, swz = sb ^ (((sb >> 9) & 1) << 5); R = (st >> 1) * 16 + swz / 64; C = (st & 1) * 32 + (swz % 64) / 2; }
__host__ __device__ __forceinline__ int perm32(int rho) { const int n = rho >> 4, i = rho & 15; return 8 * (i >> 2) + 4 * n + (i & 3); }

struct Unit { int pm, pn; };
struct Gemm { const bf16_t* A; const bf16_t* Bt; int M, N, K, ld; };

struct StaticOrder {
    int nM, nN, nwg, G, c;
    __host__ __device__ void init(int M, int N, int G_, int c_) { nM = M / BM; nN = N / BM; nwg = nM * nN; G = G_; c = c_; }
    __host__ __device__ bool next(int i, Unit& u) const {
        const long L = (long)i * G + c; if (L >= nwg) return false;
        int wgid = (int)L; { const int q = nwg / NXCD, r = nwg % NXCD, xcd = wgid % NXCD, off = wgid / NXCD; wgid = (xcd < r ? xcd * (q + 1) : r * (q + 1) + (xcd - r) * q) + off; }
        const int nig = WGM * nN, gid = wgid / nig, fm = gid * WGM, gsz = (nM - fm) < WGM ? (nM - fm) : WGM;
        u.pm = fm + ((wgid % nig) % gsz); u.pn = (wgid % nig) / gsz; return true;
    }
    __device__ __forceinline__ void a_ready(const Unit&) const {}
    __device__ __forceinline__ void done(const Unit&) const {}
};
typedef float f32x2c_ __attribute__((ext_vector_type(2)));
typedef __bf16 bf16x2c_ __attribute__((ext_vector_type(2)));
__device__ __forceinline__ unsigned cvt_pk_bf16(float lo, float hi) { return __builtin_bit_cast(unsigned, __builtin_convertvector(((f32x2c_){lo, hi}), bf16x2c_)); }
#define EPI_MFMA_SETTLE() do {} while (0)
__device__ __forceinline__ float bf_lo(unsigned w) { return __builtin_bit_cast(float, w << 16); }
__device__ __forceinline__ float bf_hi(unsigned w) { return __builtin_bit_cast(float, w & 0xffff0000u); }
__device__ __forceinline__ float sigmoid_f(float v) { return __builtin_amdgcn_rcpf(1.0f + __expf(-v)); }
__device__ __forceinline__ float silu_f(float v) { return v * sigmoid_f(v); }
template <int ACT> __device__ __forceinline__ float act_f(float v) { if (ACT == 1) return silu_f(v); if (ACT == 2) return sigmoid_f(v); return v; }
__device__ __forceinline__ u32x4 pack8(const f32x4& v0, const f32x4& v1) { u32x4 w; w.x = cvt_pk_bf16(v0[0], v0[1]); w.y = cvt_pk_bf16(v0[2], v0[3]); w.z = cvt_pk_bf16(v1[0], v1[1]); w.w = cvt_pk_bf16(v1[2], v1[3]); return w; }
__device__ __forceinline__ void unpack8(const u32x4 w, f32x4& v0, f32x4& v1) { v0 = (f32x4){bf_lo(w.x), bf_hi(w.x), bf_lo(w.y), bf_hi(w.y)}; v1 = (f32x4){bf_lo(w.z), bf_hi(w.z), bf_lo(w.w), bf_hi(w.w)}; }

struct EpiProj {
    static constexpr bool PERM = true, AFTER_DRAIN = false, KHOOK = false;
    bf16_t *U, *SZ, *MZ, *XBC, *G1, *G2;
    template <int ACT> __device__ __forceinline__ void store_tile(const f32x4 (&acc)[2][2][4][2], bf16_t* base, size_t rs, size_t bs, int row0) const {
#pragma unroll
        for (int ai = 0; ai < 2; ++ai)
#pragma unroll
            for (int m = 0; m < 4; ++m) { bf16_t* rowp = base + (size_t)(row0 + ai * HALF + m * 16) * rs;
#pragma unroll
                for (int bj = 0; bj < 2; ++bj) { f32x4 v0 = acc[ai][bj][m][0], v1 = acc[ai][bj][m][1];
#pragma unroll
                    for (int e = 0; e < 4; ++e) { v0[e] = act_f<ACT>(v0[e]); v1[e] = act_f<ACT>(v1[e]); }
                    __builtin_nontemporal_store(pack8(v0, v1), (u32x4*)(rowp + bj * bs)); } }
    }
    __device__ __forceinline__ void operator()(const f32x4 (&acc)[2][2][4][2], const Unit& u, int wr, int wc, int fr, int fq) const {
        EPI_MFMA_SETTLE();
        const int pn = u.pn, row0 = u.pm * BM + wr * 64 + fr, cl = wc * 32 + 8 * fq;
        if (pn < 16) {
            const int col = pn * BM + cl; store_tile<0>(acc, U + (size_t)(col >> 4) * (8192 * 16) + (col & 15), 16, (size_t)8 * 8192 * 16, row0);
        } else if (pn < 32) {
            store_tile<1>(acc, SZ + (pn - 16) * BM + cl, 4096, HALF, row0);
        } else if (pn < 64) {
            store_tile<1>(acc, MZ + (pn - 32) * BM + cl, 8192, HALF, row0);
        } else if (pn < 104) {
            store_tile<0>(acc, XBC + (pn - 64) * BM + cl, 10240, HALF, row0);
        } else if (pn < 120) {
            store_tile<2>(acc, G1 + (pn - 104) * BM + cl, 4096, HALF, row0);
        } else {
            store_tile<2>(acc, G2 + (pn - 120) * BM + cl, 4096, HALF, row0);
        }
    }
};
struct EpiDTP {
    static constexpr bool PERM = true, AFTER_DRAIN = false, KHOOK = false;
    float* DTP;
    __device__ __forceinline__ void operator()(const f32x4 (&acc)[2][2][4][2], const Unit& u, int wr, int wc, int fr, int fq) const {
        const int row0 = u.pm * BM + wr * 64 + fr, cl = wc * 32 + 8 * fq;
#pragma unroll
        for (int ai = 0; ai < 2; ++ai)
#pragma unroll
            for (int m = 0; m < 4; ++m) { float* rowp = DTP + ((size_t)u.pn * 8192 + row0 + ai * HALF + m * 16) * 128 + cl;
                *(f32x4*)(rowp) = acc[ai][0][m][0]; *(f32x4*)(rowp + 4) = acc[ai][0][m][1]; }
    }
};
struct EpiGlu {
    static constexpr bool PERM = true, AFTER_DRAIN = false, KHOOK = false;
    const bf16_t* SZ; const float* bias; bf16_t* O;
    __device__ __forceinline__ void operator()(const f32x4 (&acc)[2][2][4][2], const Unit& u, int wr, int wc, int fr, int fq) const {
        EPI_MFMA_SETTLE();
        const int row0 = u.pm * BM + wr * 64 + fr, j0 = u.pn * HALF + wc * 32 + 8 * fq;
        const f32x4 ba0 = *(const f32x4*)(bias + j0), ba1 = *(const f32x4*)(bias + j0 + 4), bb0 = *(const f32x4*)(bias + 4096 + j0), bb1 = *(const f32x4*)(bias + 4096 + j0 + 4);
        u32x4 zr[8];
#pragma unroll
        for (int i = 0; i < 8; ++i) zr[i] = *(const u32x4*)(SZ + (size_t)(row0 + (i >> 2) * HALF + (i & 3) * 16) * 4096 + j0);
#pragma unroll
        for (int ai = 0; ai < 2; ++ai)
#pragma unroll
            for (int m = 0; m < 4; ++m) { const size_t off = (size_t)(row0 + ai * HALF + m * 16) * 4096 + j0;
                f32x4 z0, z1; unpack8(zr[ai * 4 + m], z0, z1);
                f32x4 a0 = acc[ai][0][m][0] + ba0, a1 = acc[ai][0][m][1] + ba1, b0 = acc[ai][1][m][0] + bb0, b1 = acc[ai][1][m][1] + bb1;
#pragma unroll
                for (int e = 0; e < 4; ++e) { a0[e] = a0[e] * sigmoid_f(b0[e]) * z0[e]; a1[e] = a1[e] * sigmoid_f(b1[e]) * z1[e]; }
                *(u32x4*)(O + off) = pack8(a0, a1); }
    }
};
struct EpiBrS {
    static constexpr bool PERM = true, AFTER_DRAIN = false, KHOOK = false;
    const bf16_t* G1; bf16_t* T1;
    __device__ __forceinline__ void operator()(const f32x4 (&acc)[2][2][4][2], const Unit& u, int wr, int wc, int fr, int fq) const {
        EPI_MFMA_SETTLE();
        const int row0 = u.pm * BM + wr * 64 + fr, c0 = u.pn * BM + wc * 32 + 8 * fq;
#pragma unroll
        for (int ai = 0; ai < 2; ++ai) { u32x4 gr[8];
#pragma unroll
            for (int i = 0; i < 8; ++i) gr[i] = *(const u32x4*)(G1 + (size_t)(row0 + ai * HALF + (i >> 1) * 16) * 4096 + c0 + (i & 1) * HALF);
#pragma unroll
            for (int m = 0; m < 4; ++m)
#pragma unroll
                for (int bj = 0; bj < 2; ++bj) { const size_t off = (size_t)(row0 + ai * HALF + m * 16) * 4096 + c0 + bj * HALF;
                    f32x4 g0, g1; unpack8(gr[m * 2 + bj], g0, g1);
                    *(u32x4*)(T1 + off) = pack8(acc[ai][bj][m][0] * g0, acc[ai][bj][m][1] * g1); } }
    }
};
struct EpiBrM {
    static constexpr bool PERM = true, AFTER_DRAIN = false, KHOOK = true;
    const bf16_t* G2; const bf16_t* T1; bf16_t* O; const float* RT;
    __device__ __forceinline__ void unit_begin(const Unit& u, PG8_LAS unsigned char* tbl, int tid) const {
        const f32x4 v = *(const f32x4*)(RT + (size_t)u.pm * BM * 8 + 4 * tid); *(PG8_LAS f32x4*)(tbl + 16 * tid) = v;
    }
    __device__ __forceinline__ void khook(f32x4 (&acc)[2][2][4][2], const PG8_LAS unsigned char* tbl, int g, int wr, int fr) const {
#pragma unroll
        for (int ai = 0; ai < 2; ++ai)
#pragma unroll
            for (int m = 0; m < 4; ++m) { const float f = *(const PG8_LAS float*)(tbl + ((ai * HALF + wr * 64 + m * 16 + fr) * 8 + g) * 4);
#pragma unroll
                for (int bj = 0; bj < 2; ++bj)
#pragma unroll
                    for (int n = 0; n < 2; ++n) acc[ai][bj][m][n] = acc[ai][bj][m][n] * f; }
    }
    __device__ __forceinline__ void epi(const f32x4 (&acc)[2][2][4][2], const Unit& u, int wr, int wc, int fr, int fq, const PG8_LAS unsigned char* tbl) const {
        const int row0 = u.pm * BM + wr * 64 + fr, c0 = u.pn * BM + wc * 32 + 8 * fq;
#pragma unroll
        for (int ai = 0; ai < 2; ++ai) { u32x4 gr[8], tr[8];
#pragma unroll
            for (int i = 0; i < 8; ++i) { const size_t off = (size_t)(row0 + ai * HALF + (i >> 1) * 16) * 4096 + c0 + (i & 1) * HALF; gr[i] = *(const u32x4*)(G2 + off); tr[i] = *(const u32x4*)(T1 + off); }
#pragma unroll
            for (int m = 0; m < 4; ++m) { const float f = *(const PG8_LAS float*)(tbl + ((ai * HALF + wr * 64 + m * 16 + fr) * 8 + 7) * 4);
#pragma unroll
                for (int bj = 0; bj < 2; ++bj) { const size_t off = (size_t)(row0 + ai * HALF + m * 16) * 4096 + c0 + bj * HALF;
                    f32x4 g0, g1; unpack8(gr[m * 2 + bj], g0, g1);
                    f32x4 t0, t1; unpack8(tr[m * 2 + bj], t0, t1);
                    *(u32x4*)(O + off) = pack8(t0 + acc[ai][bj][m][0] * (g0 * f), t1 + acc[ai][bj][m][1] * (g1 * f)); } } }
    }
};
struct EpiOut {
    static constexpr bool PERM = true, AFTER_DRAIN = false, KHOOK = false;
    const float* X; const float* gate; bf16_t* O; float* SS;
    __device__ __forceinline__ void operator()(const f32x4 (&acc)[2][2][4][2], const Unit& u, int wr, int wc, int fr, int fq) const {
        EPI_MFMA_SETTLE();
        const int row0 = u.pm * BM + wr * 64 + fr, c0 = u.pn * BM + wc * 32 + 8 * fq;
        f32x4 gv[2][2];
#pragma unroll
        for (int bj = 0; bj < 2; ++bj) { gv[bj][0] = *(const f32x4*)(gate + c0 + bj * HALF); gv[bj][1] = *(const f32x4*)(gate + c0 + bj * HALF + 4); }
#pragma unroll
        for (int ai = 0; ai < 2; ++ai)
#pragma unroll
            for (int mh = 0; mh < 2; ++mh) { f32x4 xr[8];
#pragma unroll
                for (int i = 0; i < 8; ++i) xr[i] = *(const f32x4*)(X + (size_t)(row0 + ai * HALF + (2 * mh + (i >> 2)) * 16) * 4096 + c0 + ((i >> 1) & 1) * HALF + 4 * (i & 1));
#pragma unroll
                for (int mm = 0; mm < 2; ++mm) { const int m = 2 * mh + mm, row = row0 + ai * HALF + m * 16; float s = 0.f;
#pragma unroll
                    for (int bj = 0; bj < 2; ++bj) { const size_t off = (size_t)row * 4096 + c0 + bj * HALF;
                        const f32x4 o0 = xr[mm * 4 + bj * 2] + acc[ai][bj][m][0] * gv[bj][0], o1 = xr[mm * 4 + bj * 2 + 1] + acc[ai][bj][m][1] * gv[bj][1];
                        *(u32x4*)(O + off) = pack8(o0, o1);
                        s += (o0[0] * o0[0] + o0[1] * o0[1]) + (o0[2] * o0[2] + o0[3] * o0[3]) + (o1[0] * o1[0] + o1[1] * o1[1]) + (o1[2] * o1[2] + o1[3] * o1[3]); }
                    s += __shfl_xor(s, 16); s += __shfl_xor(s, 32);
                    if (fq == 0) SS[(size_t)row * 64 + u.pn * 4 + wc] = s; } }
    }
};
template <class Epi, class Sched, bool ALIGN_EPI = false, bool SP2 = false, bool SPLITK = false>
__device__ __forceinline__ void gemm_phase(PG8_LAS unsigned char* lds, const Gemm g, const Sched& S, const Epi& E) {
    const int tid = threadIdx.x, wid = __builtin_amdgcn_readfirstlane(tid >> 6), lane = tid & 63, wr = wid >> 2, wc = wid & 3, fr = lane & 15, fq = lane >> 4;
    const int K = g.K, nt = K / BK, LD = g.ld;
    unsigned voffA[2], voffB[2];
#pragma unroll
    for (int i = 0; i < 2; ++i) { int R, C; stage_rc(tid * 16 + i * 8192, R, C); const int Rb = Epi::PERM ? ((R & ~31) + perm32(R & 31)) : R;
        voffA[i] = (unsigned)(R * LD + C) * 2u; voffB[i] = (unsigned)(Rb * LD + C) * 2u; }
    const size_t kstep = (size_t)(BK * 2);
    const size_t hstep = (size_t)HALF * LD * 2;
    const size_t tstep = 2 * hstep;
    const unsigned ldsw = (unsigned)wid * 1024u;
    const int aoff = lds_byte(wr * 64 + fr, fq * 8), boff = lds_byte(wc * 32 + fr, fq * 8);
#define PG8_SA(b, h) (((b) * 2 + (h)) * HTB)
#define PG8_SB(b, h) ((4 + (b) * 2 + (h)) * HTB)
#define PG8_STAGE(bufoff, gbase, voff) do { _Pragma("unroll") for (int _i = 0; _i < 2; ++_i) \
        __builtin_amdgcn_global_load_lds((const unsigned*)((const char*)(gbase) + (voff)[_i]), (PG8_LAS unsigned*)(lds + (bufoff) + ldsw + _i * 8192), 16, 0, 0); } while (0)
#define PG8_LDA(dst, b, h) do { _Pragma("unroll") for (int m = 0; m < 4; ++m) _Pragma("unroll") for (int k = 0; k < 2; ++k) dst[m][k] = *(const PG8_LAS bf16x8*)(lds + PG8_SA(b, h) + aoff + m * 2048 + k * 1024); } while (0)
#define PG8_LDB(dst, b, h) do { _Pragma("unroll") for (int n = 0; n < 2; ++n) _Pragma("unroll") for (int k = 0; k < 2; ++k) dst[n][k] = *(const PG8_LAS bf16x8*)(lds + PG8_SB(b, h) + boff + n * 2048 + k * 1024); } while (0)
#define PG8_MMA(ai, bj, At, Bt) do { __builtin_amdgcn_s_setprio(1); _Pragma("unroll") for (int m = 0; m < 4; ++m) _Pragma("unroll") for (int n = 0; n < 2; ++n) _Pragma("unroll") for (int k = 0; k < 2; ++k) \
        acc[ai][bj][m][n] = __builtin_amdgcn_mfma_f32_16x16x32_bf16(Bt[n][k], At[m][k], acc[ai][bj][m][n], 0, 0, 0); __builtin_amdgcn_s_setprio(0); } while (0)
#define PG8_WAIT_V(n) asm volatile("s_waitcnt vmcnt(" #n ")" ::: "memory")
#define PG8_WAIT_L(n) asm volatile("s_waitcnt lgkmcnt(" #n ")" ::: "memory")
#define PG8_BAR __builtin_amdgcn_s_barrier()
#define PG8_SCHED __builtin_amdgcn_sched_barrier(0)
    Unit cur, nxt; int ui = 0;
    if (!S.next(0, cur)) return;
    f32x4 acc[2][2][4][2];
#pragma unroll
    for (int a = 0; a < 2; ++a)
#pragma unroll
        for (int b = 0; b < 2; ++b)
#pragma unroll
            for (int m = 0; m < 4; ++m)
#pragma unroll
                for (int n = 0; n < 2; ++n) acc[a][b][m][n] = (f32x4){0.f, 0.f, 0.f, 0.f};
    bf16x8 At[4][2], B0[2][2], B1[2][2];
    const char* cA = (const char*)g.A + (size_t)cur.pm * tstep + (SPLITK ? (size_t)cur.pn * K * 2 : (size_t)0); const char* cB = (const char*)g.Bt + (SPLITK ? (size_t)cur.pn * K * 2 : (size_t)cur.pn * tstep);
    S.a_ready(cur);
    if constexpr (SP2) {
        PG8_STAGE(PG8_SB(0, 0), cB, voffB); PG8_STAGE(PG8_SB(0, 1), cB + hstep, voffB); PG8_STAGE(PG8_SA(0, 0), cA, voffA); PG8_STAGE(PG8_SA(0, 1), cA + hstep, voffA);
        if (wr == 1) PG8_BAR;
        PG8_WAIT_V(2); PG8_BAR;
        PG8_STAGE(PG8_SB(1, 0), cB + kstep, voffB); PG8_STAGE(PG8_SA(1, 0), cA + kstep, voffA); PG8_STAGE(PG8_SB(1, 1), cB + hstep + kstep, voffB);
        PG8_WAIT_V(6); PG8_BAR;
    } else {
        PG8_STAGE(PG8_SB(0, 0), cB, voffB); PG8_STAGE(PG8_SA(0, 0), cA, voffA); PG8_STAGE(PG8_SB(0, 1), cB + hstep, voffB); PG8_STAGE(PG8_SA(0, 1), cA + hstep, voffA);
        if (wr == 1) PG8_BAR;
        PG8_WAIT_V(4); PG8_BAR;
        PG8_STAGE(PG8_SB(1, 0), cB + kstep, voffB); PG8_STAGE(PG8_SA(1, 0), cA + kstep, voffA); PG8_STAGE(PG8_SB(1, 1), cB + hstep + kstep, voffB);
        PG8_WAIT_V(6); PG8_BAR;
    }
    for (;;) {
        const bool has_next = S.next(ui + 1, nxt);
        if constexpr (Epi::KHOOK) E.unit_begin(cur, lds + STAGE_BYTES + (ui & 1) * 8192, tid);
        const char* nA = has_next ? (const char*)g.A + (size_t)nxt.pm * tstep + (SPLITK ? (size_t)nxt.pn * K * 2 : (size_t)0) : cA; const char* nB = has_next ? (const char*)g.Bt + (SPLITK ? (size_t)nxt.pn * K * 2 : (size_t)nxt.pn * tstep) : cB;
        for (int t = 0; t < nt; t += 2) {
            const bool last = (t == nt - 2);
            const char* a1 = cA + (size_t)(t + 1) * kstep;
            const char* a2 = last ? nA : cA + (size_t)(t + 2) * kstep; const char* b2 = last ? nB : cB + (size_t)(t + 2) * kstep;
            const char* a3 = a2 + kstep; const char* b3 = b2 + kstep;
            if (last && has_next) S.a_ready(nxt);
            if constexpr (SP2) {
            PG8_LDB(B0, 0, 0); PG8_LDB(B1, 0, 1); PG8_SCHED; PG8_LDA(At, 0, 0); PG8_STAGE(PG8_SA(1, 1), a1 + hstep, voffA);
            PG8_WAIT_V(8); PG8_WAIT_L(0); PG8_BAR; PG8_MMA(0, 0, At, B0); PG8_MMA(0, 1, At, B1); PG8_BAR; PG8_SCHED;
            PG8_LDA(At, 0, 1); PG8_STAGE(PG8_SB(0, 0), b2, voffB); PG8_STAGE(PG8_SB(0, 1), b2 + hstep, voffB); PG8_STAGE(PG8_SA(0, 0), a2, voffA);
            PG8_WAIT_V(8); PG8_WAIT_L(0); PG8_BAR; PG8_MMA(1, 0, At, B0); PG8_MMA(1, 1, At, B1); PG8_BAR; PG8_SCHED;
            PG8_LDB(B0, 1, 0); PG8_LDB(B1, 1, 1); PG8_SCHED; PG8_LDA(At, 1, 0); PG8_STAGE(PG8_SA(0, 1), a2 + hstep, voffA);
            PG8_WAIT_V(8); PG8_WAIT_L(0); PG8_BAR; PG8_MMA(0, 0, At, B0); PG8_MMA(0, 1, At, B1); PG8_BAR; PG8_SCHED;
            PG8_LDA(At, 1, 1); PG8_STAGE(PG8_SB(1, 0), b3, voffB); PG8_STAGE(PG8_SB(1, 1), b3 + hstep, voffB); PG8_STAGE(PG8_SA(1, 0), a3, voffA);
            PG8_WAIT_V(8); PG8_WAIT_L(0); PG8_BAR; PG8_MMA(1, 0, At, B0); PG8_MMA(1, 1, At, B1); PG8_BAR; PG8_SCHED;
            if constexpr (Epi::KHOOK) { if ((t & 15) == 14 && !last) { E.khook(acc, lds + STAGE_BYTES + (ui & 1) * 8192, t >> 4, wr, fr); } }
            } else {
            PG8_LDB(B0, 0, 0); PG8_SCHED; PG8_LDA(At, 0, 0); PG8_STAGE(PG8_SA(1, 1), a1 + hstep, voffA);
            PG8_WAIT_L(8); PG8_BAR; PG8_WAIT_L(0); PG8_MMA(0, 0, At, B0); PG8_BAR; PG8_SCHED;
            PG8_LDB(B1, 0, 1); PG8_STAGE(PG8_SB(0, 0), b2, voffB);
            PG8_BAR; PG8_WAIT_L(0); PG8_MMA(0, 1, At, B1); PG8_BAR;
            PG8_LDA(At, 0, 1); PG8_STAGE(PG8_SA(0, 0), a2, voffA);
            PG8_BAR; PG8_WAIT_L(0); PG8_MMA(1, 0, At, B0); PG8_BAR; PG8_SCHED;
            PG8_STAGE(PG8_SB(0, 1), b2 + hstep, voffB);
            PG8_WAIT_V(6); PG8_BAR; PG8_MMA(1, 1, At, B1); PG8_BAR;
            PG8_LDB(B0, 1, 0); PG8_SCHED; PG8_LDA(At, 1, 0); PG8_STAGE(PG8_SA(0, 1), a2 + hstep, voffA);
            PG8_WAIT_L(8); PG8_BAR; PG8_WAIT_L(0); PG8_MMA(0, 0, At, B0); PG8_BAR; PG8_SCHED;
            PG8_LDB(B1, 1, 1); PG8_STAGE(PG8_SB(1, 0), b3, voffB);
            PG8_BAR; PG8_WAIT_L(0); PG8_MMA(0, 1, At, B1); PG8_BAR;
            PG8_LDA(At, 1, 1); PG8_STAGE(PG8_SA(1, 0), a3, voffA);
            PG8_BAR; PG8_WAIT_L(0); PG8_MMA(1, 0, At, B0); PG8_BAR; PG8_SCHED;
            PG8_STAGE(PG8_SB(1, 1), b3 + hstep, voffB);
            PG8_WAIT_V(6); PG8_BAR; PG8_MMA(1, 1, At, B1); PG8_BAR;
            }
        }
        if constexpr (ALIGN_EPI) { if (wr == 0) PG8_BAR; }
        if constexpr (!Epi::AFTER_DRAIN) { if constexpr (Epi::KHOOK) E.epi(acc, cur, wr, wc, fr, fq, lds + STAGE_BYTES + (ui & 1) * 8192); else E(acc, cur, wr, wc, fr, fq); S.done(cur); }
        if (!has_next) break;
#pragma unroll
        for (int a = 0; a < 2; ++a)
#pragma unroll
            for (int b = 0; b < 2; ++b)
#pragma unroll
                for (int m = 0; m < 4; ++m)
#pragma unroll
                    for (int n = 0; n < 2; ++n) acc[a][b][m][n] = (f32x4){0.f, 0.f, 0.f, 0.f};
        cur = nxt; cA = nA; cB = nB; ++ui;
        if constexpr (ALIGN_EPI) { if (wr == 1) PG8_BAR; }
    }
    PG8_WAIT_V(0);
    if constexpr (!ALIGN_EPI) { if (wr == 0) PG8_BAR; }
    PG8_BAR;
    if constexpr (Epi::AFTER_DRAIN) { E.fused(acc, cur, wr, wc, fr, fq, lds, wid, lane); S.done(cur); }
#undef PG8_SA
#undef PG8_SB
#undef PG8_STAGE
#undef PG8_LDA
#undef PG8_LDB
#undef PG8_MMA
#undef PG8_WAIT_V
#undef PG8_WAIT_L
#undef PG8_BAR
#undef PG8_SCHED
}
}
#ifndef PG8_SP2
#define PG8_SP2 true
#endif
#ifndef PG8_ALIGN
#define PG8_ALIGN true
#endif
constexpr int NWAVES = 8;
#ifndef MK_N_LAUNCHES
#define MK_N_LAUNCHES 1
#endif
constexpr int NPH = 11;
constexpr int N_LAUNCHES = MK_N_LAUNCHES;

constexpr int M = 8192, D = 4096;
constexpr int S5G = 256, S5P = 16, S5N = 64;
constexpr int DI = 8192, NH = 128, HD = 64, NG = 8, NS = 128, CONVD = 10240;
constexpr int IN_COLS = 34944, NPROJ = 35072, NMAIN = 34816;
constexpr float EPS = 1e-6f;

constexpr size_t MiB = 1u << 20;
constexpr size_t WS_CTL = 0, CTL_ZERO_BYTES = 1 * MiB;
constexpr size_t WS_MODP = 1 * MiB;
constexpr size_t WS_GATE = 1 * MiB + 512 * 1024;
constexpr size_t WS_SS = 2 * MiB;
constexpr size_t WS_S5C = 2 * MiB;
constexpr size_t WS_DT = 4 * MiB;
constexpr size_t WS_WGLU = 8 * MiB, WS_WBRS = 72 * MiB, WS_WBRM = 104 * MiB, WS_WOUT = 168 * MiB;
constexpr size_t WS_U = 200 * MiB;
constexpr size_t WS_SZ = 264 * MiB;
constexpr size_t WS_MZ = 328 * MiB;
constexpr size_t WS_XBC = 456 * MiB;
constexpr size_t WS_G1 = 616 * MiB, WS_G2 = 680 * MiB;
constexpr size_t WS_WIN = 744 * MiB;
constexpr size_t WS_YSSD = 744 * MiB, WS_YM2 = 872 * MiB;
constexpr size_t WS_H = 1018 * MiB;
constexpr size_t WS_YS5 = 1018 * MiB;
constexpr size_t WS_XC = 1082 * MiB;
constexpr size_t WS_DTS = 1242 * MiB;
constexpr size_t WS_END = 1246 * MiB;
constexpr size_t WS_YS5G = WS_U, WS_MERGED = WS_SZ, WS_T1 = WS_MZ;
constexpr size_t WS_X2 = WS_G1;
static_assert(WS_WIN + (size_t)NPROJ * D * 2 <= WS_H && WS_H + (size_t)M * D * 2 <= WS_XC && WS_XC + (size_t)M * CONVD * 2 <= WS_DTS, "d_ws map");
constexpr int CW_BAR = 4096;

constexpr int RING_OFF = 0, RING_BYTES = 131072;
constexpr int LDSCTL_OFF = 151552, MISC_OFF = LDSCTL_OFF + 320;
constexpr int LDS_BYTES = 155648;
static_assert(MISC_OFF + 128 <= LDS_BYTES, "LDS map");

#define GAS __attribute__((address_space(1)))
#define LAS __attribute__((address_space(3)))
typedef unsigned short bf16;
typedef unsigned v4u __attribute__((ext_vector_type(4)));
typedef unsigned v2u __attribute__((ext_vector_type(2)));
typedef float f32x4 __attribute__((ext_vector_type(4)));
typedef short bf16x8 __attribute__((ext_vector_type(8)));
typedef GAS unsigned gu32;
#define RLX_AGENT __ATOMIC_RELAXED, __HIP_MEMORY_SCOPE_AGENT
#define LDS_WAIT() asm volatile("s_waitcnt lgkmcnt(0)" ::: "memory")
#define VM_WAIT() asm volatile("s_waitcnt vmcnt(0)" ::: "memory")
typedef float f32x2c __attribute__((ext_vector_type(2)));
typedef __bf16 bf16x2c __attribute__((ext_vector_type(2)));
__device__ __forceinline__ unsigned pk2(float lo, float hi) { return __builtin_bit_cast(unsigned, __builtin_convertvector(((f32x2c){lo, hi}), bf16x2c)); }
__device__ __forceinline__ unsigned f2bf(float f) { return pk2(f, 0.f) & 0xffffu; }
__device__ __forceinline__ float bf2f(bf16 h) { return __builtin_bit_cast(float, (unsigned)h << 16); }
using pg8::bf_lo; using pg8::bf_hi;
#define XB_TMO      128
#define XB_XCNT(j)  (256  + 64 * (j))
#define XB_XSUB(j)  (1280 + 64 * (j))
#define XB_XGEN(j)  (2304 + 64 * (j))
#define XB_TOP      3328
#define XB_TOPGEN   3392
#define XCD_BAR_WORDS 3456
#define XB_SPIN_CAP (1u << 18)

__device__ __forceinline__ unsigned xb_ld(unsigned* p)              { return __hip_atomic_load(p, __ATOMIC_RELAXED, __HIP_MEMORY_SCOPE_AGENT); }
__device__ __forceinline__ unsigned xb_add(unsigned* p, unsigned v) { return __hip_atomic_fetch_add(p, v, __ATOMIC_RELAXED, __HIP_MEMORY_SCOPE_AGENT); }
__device__ __forceinline__ unsigned xb_xcc_id() { return (unsigned)__builtin_amdgcn_s_getreg((3 << 11) | 20) & 0xFu; }
#define XB_SPIN(cond, bar) do { unsigned _sp = 0; while (cond) { __builtin_amdgcn_s_sleep(1); \
    if ((++_sp & 255u) == 0u) { if (xb_ld(&(bar)[XB_TMO])) break; if (_sp > XB_SPIN_CAP) { atomicAdd(&(bar)[XB_TMO], 1u); break; } } } } while (0)

struct XcdBarrier {
    unsigned* bar; unsigned x;
    volatile LAS unsigned* st;
};

__device__ __forceinline__ XcdBarrier xcd_barrier_post(unsigned* bar, volatile LAS unsigned* st) {
    XcdBarrier b; b.bar = bar; b.x = xb_xcc_id(); b.st = st;
    if (threadIdx.x == 0) (void)xb_add(&bar[XB_XCNT(b.x)], 1u);
    return b;
}
__device__ __forceinline__ void xcd_barrier_complete(unsigned* bar, unsigned x, unsigned& nloc, unsigned& nx) {
    const unsigned G = gridDim.x * gridDim.y * gridDim.z;
    unsigned sum, cnt, mine, sp = 0u;
    for (;;) {
        sum = 0u; cnt = 0u; mine = 0u;
#pragma unroll
        for (unsigned j = 0; j < 16; ++j) { const unsigned c = xb_ld(&bar[XB_XCNT(j)]); sum += c; cnt += (c > 0u) ? 1u : 0u; mine = (j == x) ? c : mine; }
        if (sum == G) break;
        __builtin_amdgcn_s_sleep(1);
        if ((++sp & 255u) == 0u) { if (xb_ld(&bar[XB_TMO])) break; if (sp > XB_SPIN_CAP) { atomicAdd(&bar[XB_TMO], 1u); break; } }
    }
    nloc = mine > 0u ? mine : 1u; nx = cnt > 0u ? cnt : 1u;
}

__device__ __forceinline__ void xcd_barrier(const XcdBarrier& b) {
    asm volatile("s_waitcnt vmcnt(0)" ::: "memory");
    __syncthreads();
    if (threadIdx.x == 0) {
        unsigned* bar = b.bar;
        __builtin_amdgcn_s_waitcnt(0);
        unsigned nloc = b.st[0], nx = b.st[1];
        if (nloc == 0u) { xcd_barrier_complete(bar, b.x, nloc, nx); b.st[0] = nloc; b.st[1] = nx; }
        const unsigned old = xb_add(&bar[XB_XSUB(b.x)], 1u);
        const unsigned gen = old / nloc;
        if (old + 1u == (gen + 1u) * nloc) {
            __builtin_amdgcn_fence(__ATOMIC_RELEASE, "agent");
            asm volatile("s_waitcnt vmcnt(0)" ::: "memory");
            const unsigned og = xb_add(&bar[XB_TOP], 1u);
            const unsigned tg = og / nx;
            if (og + 1u == (tg + 1u) * nx) xb_add(&bar[XB_TOPGEN], 1u);
            else XB_SPIN(xb_ld(&bar[XB_TOPGEN]) == tg, bar);
            __builtin_amdgcn_fence(__ATOMIC_ACQUIRE, "agent");
            xb_add(&bar[XB_XGEN(b.x)], 1u);
            asm volatile("s_waitcnt vmcnt(0)" ::: "memory");
        } else {
            XB_SPIN(xb_ld(&bar[XB_XGEN(b.x)]) == gen, bar);
            __builtin_amdgcn_fence(__ATOMIC_ACQUIRE, "agent");
            asm volatile("s_waitcnt vmcnt(0)" ::: "memory");
        }
    }
    __syncthreads();
}
__device__ __forceinline__ float wave_sum(float v) {
#pragma unroll
    for (int o = 1; o < 64; o <<= 1) v += __shfl_xor(v, o);
    return v;
}
constexpr int TR_PITCH = 34, TR_BYTES = 64 * TR_PITCH * 2;
__device__ __forceinline__ void p0_transpose_item(const float* W, int K, int N, bf16* WT, int src_n0, int dst_n0, int k0, LAS bf16* scr, int lane, const float* kscale = nullptr) {
    if (src_n0 >= 0) {
        f32x4 v[8];
#pragma unroll
        for (int i = 0; i < 8; ++i) v[i] = __builtin_nontemporal_load((const GAS f32x4*)(W + (size_t)(k0 + 8 * i + (lane >> 3)) * N + src_n0 + 4 * (lane & 7)));
        if (kscale) {
#pragma unroll
            for (int i = 0; i < 8; ++i) v[i] = v[i] * kscale[k0 + 8 * i + (lane >> 3)]; }
#pragma unroll
        for (int i = 0; i < 8; ++i) { LAS unsigned* d = (LAS unsigned*)(scr + (8 * i + (lane >> 3)) * TR_PITCH + 4 * (lane & 7)); d[0] = pk2(v[i].x, v[i].y); d[1] = pk2(v[i].z, v[i].w); }
    } else {
#pragma unroll
        for (int i = 0; i < 8; ++i) { LAS unsigned* d = (LAS unsigned*)(scr + (8 * i + (lane >> 3)) * TR_PITCH + 4 * (lane & 7)); d[0] = 0u; d[1] = 0u; }
    }
    LDS_WAIT(); asm volatile("" ::: "memory");
    const int c = lane & 7;
#pragma unroll
    for (int j = 0; j < 4; ++j) { const int n = (lane >> 3) + 8 * j; const LAS bf16* s = scr + (8 * c) * TR_PITCH + n;
        v4u o; o.x = (unsigned)s[0] | ((unsigned)s[TR_PITCH] << 16); o.y = (unsigned)s[2 * TR_PITCH] | ((unsigned)s[3 * TR_PITCH] << 16);
        o.z = (unsigned)s[4 * TR_PITCH] | ((unsigned)s[5 * TR_PITCH] << 16); o.w = (unsigned)s[6 * TR_PITCH] | ((unsigned)s[7 * TR_PITCH] << 16);
        *(GAS v4u*)(WT + (size_t)(dst_n0 + n) * K + k0 + 8 * c) = o; }
    LDS_WAIT(); asm volatile("" ::: "memory");
}
__device__ __forceinline__ int win_src_col(int d) { return d < 26624 ? d : (d < 34816 ? d + 128 : (d < 34944 ? d - 34816 + 26624 : -1)); }
__device__ __forceinline__ int wglu_src_col(int d) { const int pn = d >> 8, r = d & 255; return r < 128 ? 128 * pn + r : 4096 + 128 * pn + (r - 128); }

struct Args {
    const float *x, *c, *w_ada, *b_ada, *norm_g, *w_in, *lam_re, *lam_im, *log_step, *b_re, *b_im, *c_re, *c_im, *s5_d, *w_glu, *b_glu,
                *conv_w, *conv_b, *dt_bias, *a_log, *m2_d, *m2_norm_g, *w_br_s5, *w_br_m2, *w_out, *final_g;
    float* out; unsigned char* ws; int ph_lo, ph_hi, sub, pad;
};

__device__ __forceinline__ void p0_gemv(const float* c, const float* W, float* MODP, LAS float* red, int wg, int G, int tid) {
    const int cg = tid & 31, rg = tid >> 5;
    for (int it = wg; it < 768; it += G) {
        const int cb = it % 96, ks = it / 96;
        const float* wp = W + (size_t)(ks * 512 + rg) * 12288 + cb * 128 + cg * 4;
        const float* cp = c + ks * 512 + rg;
        f32x4 acc = (f32x4){0.f, 0.f, 0.f, 0.f};
#pragma unroll 8
        for (int i = 0; i < 32; ++i) { const f32x4 w = __builtin_nontemporal_load((const f32x4*)(wp + (size_t)i * 16 * 12288)); const float cv = cp[i * 16]; acc = acc + w * cv; }
        *(LAS f32x4*)(red + rg * 128 + cg * 4) = acc;
        __syncthreads();
        if (tid < 128) { float s = 0.f;
#pragma unroll
            for (int r = 0; r < 16; ++r) s += red[r * 128 + tid];
            MODP[ks * 12288 + cb * 128 + tid] = s; }
        __syncthreads();
    }
}
__device__ __forceinline__ void p0_weights_in(const Args& a, LAS bf16* scr, int gw, int NGW, int lane) {
    bf16* WIN = (bf16*)(a.ws + WS_WIN);
    constexpr int I_IN = (D / 64) * (NPROJ / 32);
    for (int r = gw; r < I_IN; r += NGW) { const int nblk = NPROJ / 32, kb = r / nblk, nb = r % nblk; p0_transpose_item(a.w_in, D, IN_COLS, WIN, win_src_col(32 * nb), 32 * nb, 64 * kb, scr, lane); }
}
constexpr int P3_NCONV = 16 * 512, P3_NWITEMS = (D / 64) * (8192 / 32) + 2 * (D / 64) * (D / 32) + (DI / 64) * (D / 32);
__device__ __forceinline__ void p3_weight_item(const Args& a, LAS bf16* scr, int it, int lane) {
    bf16* WGLU = (bf16*)(a.ws + WS_WGLU); bf16* WBRS = (bf16*)(a.ws + WS_WBRS); bf16* WBRM = (bf16*)(a.ws + WS_WBRM); bf16* WOUT = (bf16*)(a.ws + WS_WOUT);
    constexpr int I_GLU = (D / 64) * (8192 / 32), I_BRS = (D / 64) * (D / 32), I_BRM = (DI / 64) * (D / 32), I_OUT = (D / 64) * (D / 32);
    static_assert(I_GLU + I_BRS + I_BRM + I_OUT == P3_NWITEMS, "item count");
    int r = it;
    if (r < I_GLU) { const int nblk = 8192 / 32, kb = r / nblk, nb = r % nblk; p0_transpose_item(a.w_glu, D, 8192, WGLU, wglu_src_col(32 * nb), 32 * nb, 64 * kb, scr, lane); return; } r -= I_GLU;
    if (r < I_BRS) { const int nblk = D / 32, kb = r / nblk, nb = r % nblk; p0_transpose_item(a.w_br_s5, D, D, WBRS, 32 * nb, 32 * nb, 64 * kb, scr, lane); return; } r -= I_BRS;
    if (r < I_BRM) { const int nblk = D / 32, kb = r / nblk, nb = r % nblk; p0_transpose_item(a.w_br_m2, DI, D, WBRM, 32 * nb, 32 * nb, 64 * kb, scr, lane, a.m2_norm_g); return; } r -= I_BRM;
    { const int nblk = D / 32, kb = r / nblk, nb = r % nblk; p0_transpose_item(a.w_out, D, D, WOUT, 32 * nb, 32 * nb, 64 * kb, scr, lane); }
}
__device__ __forceinline__ void p1_h(const Args& a, LAS float* ldsA, LAS float* ldsB, int gw, int NGW, int tid, int lane) {
    const float* MODP = (const float*)(a.ws + WS_MODP); float* GATE = (float*)(a.ws + WS_GATE); bf16* H = (bf16*)(a.ws + WS_H);
    for (int j = tid; j < 12288; j += NWAVES * 64) { float s = a.b_ada[j];
#pragma unroll
        for (int ks = 0; ks < 8; ++ks) s += MODP[ks * 12288 + j];
        if (j < 4096) ldsB[j] = s; else if (j < 8192) ldsA[j - 4096] = a.norm_g[j - 4096] * (1.0f + s); else if (blockIdx.x == 0) GATE[j - 8192] = s; }
    __syncthreads();
    for (int row = gw; row < M; row += NGW) {
        const GAS f32x4* xr = (const GAS f32x4*)(a.x + (size_t)row * D);
        f32x4 v[16]; float ss = 0.f;
#pragma unroll
        for (int j = 0; j < 8; ++j) { v[2 * j] = __builtin_nontemporal_load(xr + 128 * j + 2 * lane); v[2 * j + 1] = __builtin_nontemporal_load(xr + 128 * j + 2 * lane + 1); }
#pragma unroll
        for (int j = 0; j < 16; ++j) ss += (v[j].x * v[j].x + v[j].y * v[j].y) + (v[j].z * v[j].z + v[j].w * v[j].w);
        const float rstd = 1.0f / sqrtf(wave_sum(ss) * (1.0f / D) + EPS);
#pragma unroll
        for (int j = 0; j < 8; ++j) { const int col = 512 * j + 8 * lane;
            const f32x4 a0 = *(const LAS f32x4*)(ldsA + col), a1 = *(const LAS f32x4*)(ldsA + col + 4), b0 = *(const LAS f32x4*)(ldsB + col), b1 = *(const LAS f32x4*)(ldsB + col + 4);
            const f32x4 h0 = v[2 * j] * rstd * a0 + b0, h1 = v[2 * j + 1] * rstd * a1 + b1;
            v4u o; o.x = pk2(h0.x, h0.y); o.y = pk2(h0.z, h0.w); o.z = pk2(h1.x, h1.y); o.w = pk2(h1.z, h1.w);
            *(GAS v4u*)(H + (size_t)row * D + col) = o; }
    }
}
__device__ __forceinline__ float gelu_tanh(float x) { const float z = 0.7978845608028654f * (x + 0.044715f * x * x * x); return x * __builtin_amdgcn_rcpf(1.0f + __expf(-2.0f * z)); }
__device__ __forceinline__ float softplus_f(float x) { return fmaxf(x, 0.f) + log1pf(expf(-fabsf(x))); }
__device__ __forceinline__ void conv_task(const Args& a, int task, int lane) {
    const bf16* XBC = (const bf16*)(a.ws + WS_XBC); bf16* XC = (bf16*)(a.ws + WS_XC);
    {
        const int cb = task & 15, t0 = (task >> 4) * 16;
        const int c8 = (cb * 64 + lane) * 8;
        f32x4 w0[4], w1[4];
#pragma unroll
        for (int k = 0; k < 4; ++k) { w0[k] = *(const f32x4*)(a.conv_w + k * CONVD + c8); w1[k] = *(const f32x4*)(a.conv_w + k * CONVD + c8 + 4); }
        const f32x4 b0 = *(const f32x4*)(a.conv_b + c8), b1 = *(const f32x4*)(a.conv_b + c8 + 4);
        v4u raw[19];
#pragma unroll
        for (int i = 0; i < 19; ++i) { const int tt = t0 - 3 + i; raw[i] = (v4u){0u, 0u, 0u, 0u}; if (tt >= 0) raw[i] = __builtin_nontemporal_load((const GAS v4u*)(XBC + (size_t)tt * CONVD + c8)); }
        f32x4 r0[4], r1[4];
#pragma unroll
        for (int i = 0; i < 3; ++i) pg8::unpack8(raw[i], r0[i], r1[i]);
#pragma unroll
        for (int i = 3; i < 19; ++i) { pg8::unpack8(raw[i], r0[i & 3], r1[i & 3]);
            f32x4 acc0 = b0, acc1 = b1;
#pragma unroll
            for (int k = 0; k < 4; ++k) { acc0 = acc0 + r0[(i - 3 + k) & 3] * w0[k]; acc1 = acc1 + r1[(i - 3 + k) & 3] * w1[k]; }
#pragma unroll
            for (int e = 0; e < 4; ++e) { acc0[e] = pg8::silu_f(acc0[e]); acc1[e] = pg8::silu_f(acc1[e]); }
            v4u o; o.x = pk2(acc0.x, acc0.y); o.y = pk2(acc0.z, acc0.w); o.z = pk2(acc1.x, acc1.y); o.w = pk2(acc1.z, acc1.w);
            *(GAS v4u*)(XC + (size_t)(t0 + i - 3) * CONVD + c8) = o; }
    }
}
__device__ __forceinline__ void final_norm(const Args& a, int gw, int NGW, int lane) {
    const float* SS = (const float*)(a.ws + WS_SS); const bf16* X2 = (const bf16*)(a.ws + WS_X2);
    for (int row = gw; row < M; row += NGW) {
        const GAS v4u* xr = (const GAS v4u*)(X2 + (size_t)row * D); GAS f32x4* orow = (GAS f32x4*)(a.out + (size_t)row * D);
        v4u r[8];
#pragma unroll
        for (int j = 0; j < 8; ++j) r[j] = xr[64 * j + lane];
        const float rstd = 1.0f / sqrtf(wave_sum(SS[(size_t)row * 64 + lane]) * (1.0f / D) + EPS);
#pragma unroll
        for (int j = 0; j < 8; ++j) { const int col = 512 * j + 8 * lane; f32x4 v0, v1; pg8::unpack8(r[j], v0, v1);
            orow[128 * j + 2 * lane] = v0 * rstd * *(const f32x4*)(a.final_g + col); orow[128 * j + 2 * lane + 1] = v1 * rstd * *(const f32x4*)(a.final_g + col + 4); }
    }
}
constexpr int P3_CNT_OFF = 139264;
__device__ __forceinline__ void p3_stream_items(const Args& a, LAS unsigned char* L, LAS bf16* scr, int vcu, int G, int lane) {
    LAS unsigned* cnt = (LAS unsigned*)(L + P3_CNT_OFF);
    for (;;) {
        unsigned idx = 0u; if (lane == 0) idx = __hip_atomic_fetch_add(cnt, 1u, __ATOMIC_RELAXED, __HIP_MEMORY_SCOPE_WORKGROUP);
        idx = (unsigned)__builtin_amdgcn_readfirstlane((int)idx);
        const long id = (long)idx * G + vcu;
        if (id < P3_NCONV) conv_task(a, (int)id, lane);
        else if (id < P3_NCONV + P3_NWITEMS) p3_weight_item(a, scr, (int)(id - P3_NCONV), lane);
        else break;
    }
}
__device__ __forceinline__ void s5_consts(const Args& a, size_t gt, size_t NT) {
    float* S5C = (float*)(a.ws + WS_S5C);
    for (size_t idx = gt; idx < (size_t)S5G * S5N; idx += NT) {
        const int g = (int)(idx >> 6);
        const double step = exp((double)a.log_step[g]);
        const double lre = (double)a.lam_re[idx], lim = (double)a.lam_im[idx];
        const double mag = exp(lre * step), ang = lim * step;
        const double lbr_d = mag * cos(ang), lbi_d = mag * sin(ang);
        const double den = lre * lre + lim * lim, nr = lbr_d - 1.0, ni = lbi_d;
        const double cr = (nr * lre + ni * lim) / den, ci = (ni * lre - nr * lim) / den;
        const float lbr = (float)lbr_d, lbi = (float)lbi_d;
        double pr = (double)lbr, pi = (double)lbi;
#pragma unroll 1
        for (int i = 0; i < 11; ++i) { const double r2 = pr * pr - pi * pi, i2 = 2.0 * pr * pi; pr = r2; pi = i2; }
        *(f32x4*)(S5C + idx * 8) = (f32x4){lbr, lbi, (float)cr, (float)ci}; *(f32x4*)(S5C + idx * 8 + 4) = (f32x4){(float)pr, (float)pi, 0.f, 0.f};
    }
}
constexpr int S5W = 4, S5_SEG = M / S5W, S5_NCH = S5_SEG / 128, S5_NNB = S5_SEG / 256, S5_TQ = 8 / S5W;
constexpr int S5_APP = 264;
constexpr int S5_WLDS = 16896, S5_BU = 0, S5_SB = 8448, S5_US = 12800, S5_E = 8 * S5_WLDS;
typedef float f32x2v __attribute__((ext_vector_type(2)));
#define MFMA16(a, b, c) __builtin_amdgcn_mfma_f32_16x16x32_bf16((a), (b), (c), 0, 0, 0)
__device__ __forceinline__ void s5_bu_to_lds(const bf16x8 (&Af)[8], const bf16x8 Bf, LAS float* Bu, int lane) {
#pragma unroll
    for (int mb = 0; mb < 8; ++mb) { const f32x4 d = MFMA16(Af[mb], Bf, ((f32x4){0.f, 0.f, 0.f, 0.f})); *(LAS f32x4*)(Bu + (lane & 15) * 132 + 16 * mb + 4 * (lane >> 4)) = d; }
    LDS_WAIT(); asm volatile("" ::: "memory");
}
template <bool FULL> __device__ __forceinline__ void s5_sub(const bf16x8 (&Af)[8], const bf16x8 (&Cf)[4], const f32x4 d4, const bf16x8 Bf, const v2u u4raw, float& sr, float& si, float lbr, float lbi,
                                                            LAS float* Bu, LAS bf16* Sb, bf16* yrow, int lane) {
    s5_bu_to_lds(Af, Bf, Bu, lane);
    f32x2v b[16];
#pragma unroll
    for (int t = 0; t < 16; ++t) b[t] = *(const LAS f32x2v*)(Bu + t * 132 + 2 * lane);
#pragma unroll
    for (int t = 0; t < 16; ++t) { const float nsr = fmaf(lbr, sr, fmaf(-lbi, si, b[t].x)), nsi = fmaf(lbr, si, fmaf(lbi, sr, b[t].y)); sr = nsr; si = nsi;
        if (FULL) *(LAS unsigned*)(Sb + t * 136 + 2 * lane) = pk2(sr, si); }
    if (FULL) {
        LDS_WAIT(); asm volatile("" ::: "memory");
        f32x4 acc = (f32x4){0.f, 0.f, 0.f, 0.f};
#pragma unroll
        for (int kb = 0; kb < 4; ++kb) { const bf16x8 Sf = *(const LAS bf16x8*)(Sb + (lane & 15) * 136 + 32 * kb + 8 * (lane >> 4)); acc = MFMA16(Cf[kb], Sf, acc); }
        const float u0 = bf_lo(u4raw.x), u1 = bf_hi(u4raw.x), u2 = bf_lo(u4raw.y), u3 = bf_hi(u4raw.y);
        const float y0 = gelu_tanh(acc[0] + d4[0] * u0), y1 = gelu_tanh(acc[1] + d4[1] * u1), y2 = gelu_tanh(acc[2] + d4[2] * u2), y3 = gelu_tanh(acc[3] + d4[3] * u3);
        v2u o; o.x = pk2(y0, y1); o.y = pk2(y2, y3);
        *(GAS v2u*)(yrow + (size_t)(lane & 15) * D + 4 * (lane >> 4)) = o;
        asm volatile("" ::: "memory");
    }
}
__device__ __forceinline__ void s5_fast_group(const Args& a, int g, LAS unsigned char* L, int vcu, int G, int wave, int lane) {
    const bf16* U = (const bf16*)(a.ws + WS_U); bf16* YS5 = (bf16*)(a.ws + WS_YS5);
    LAS float* Bu = (LAS float*)(L + wave * S5_WLDS + S5_BU); LAS bf16* Sb = (LAS bf16*)(L + wave * S5_WLDS + S5_SB); LAS f32x2v* E = (LAS f32x2v*)(L + S5_E);
    float lbr, lbi, pwr, pwi;
    const float* S5C = (const float*)(a.ws + WS_S5C);
    { const f32x4 c0 = *(const f32x4*)(S5C + (size_t)(g * 64 + lane) * 8); const f32x2v c1 = *(const f32x2v*)(S5C + (size_t)(g * 64 + lane) * 8 + 4);
      lbr = c0[0]; lbi = c0[1]; pwr = c1.x; pwi = c1.y; }
    const bf16* ug = U + (size_t)g * M * 16; const int tw = wave * S5_SEG;
    LAS unsigned char* Us = L + wave * S5_WLDS + S5_US;
    const GAS v4u* useg = (const GAS v4u*)(ug + (size_t)tw * 16);
    const int bf_off = 32 * (lane & 15) + 16 * (lane >> 4), u4_off = 32 * (lane & 15) + 8 * (lane >> 4);
    {   LAS bf16* AP = (LAS bf16*)L;
#pragma unroll 1
        for (int tq = wave * S5_TQ; tq < (wave + 1) * S5_TQ; ++tq) { const int n = lane; const int e0 = 14 - 2 * tq;
          const f32x4 c0 = *(const f32x4*)(S5C + (size_t)(g * 64 + n) * 8);
          float pr = 1.f, pi = 0.f;
          for (int k = 0; k < e0; ++k) { const float r2 = pr * c0[0] - pi * c0[1], i2 = pr * c0[1] + pi * c0[0]; pr = r2; pi = i2; }
          const float qr = pr * c0[0] - pi * c0[1], qi = pr * c0[1] + pi * c0[0];
          const float* pbr = a.b_re + (size_t)(g * 64 + n) * 16; const float* pbi = a.b_im + (size_t)(g * 64 + n) * 16;
          LAS bf16* rre = AP + (32 * (n >> 4) + (n & 15)) * S5_APP + 32 * tq; LAS bf16* rim = rre + 16 * S5_APP;
#pragma unroll
          for (int q4 = 0; q4 < 4; ++q4) { const f32x4 br = *(const f32x4*)(pbr + 4 * q4), bi = *(const f32x4*)(pbi + 4 * q4);
              float xr[4], xi[4], yr[4], yi[4];
#pragma unroll
              for (int e = 0; e < 4; ++e) { const float bbr = c0[2] * br[e] - c0[3] * bi[e], bbi = c0[2] * bi[e] + c0[3] * br[e];
                  xr[e] = qr * bbr - qi * bbi; xi[e] = qr * bbi + qi * bbr; yr[e] = pr * bbr - pi * bbi; yi[e] = pr * bbi + pi * bbr; }
              *(LAS v2u*)(rre + 4 * q4) = (v2u){pk2(xr[0], xr[1]), pk2(xr[2], xr[3])}; *(LAS v2u*)(rim + 4 * q4) = (v2u){pk2(xi[0], xi[1]), pk2(xi[2], xi[3])};
              *(LAS v2u*)(rre + 16 + 4 * q4) = (v2u){pk2(yr[0], yr[1]), pk2(yr[2], yr[3])}; *(LAS v2u*)(rim + 16 + 4 * q4) = (v2u){pk2(yi[0], yi[1]), pk2(yi[2], yi[3])}; } }
        __syncthreads();
        float mur[4], mui[4], m13r[4], m13i[4], wqr[4], wqi[4];
#pragma unroll
        for (int mp = 0; mp < 4; ++mp) { const f32x2v lb = *(const f32x2v*)(S5C + (size_t)(g * 64 + 16 * mp + (lane & 15)) * 8);
            float r = lb.x, i = lb.y;
#pragma unroll
            for (int k = 0; k < 4; ++k) { const float r2 = r * r - i * i, i2 = 2.f * r * i; r = r2; i = i2; }
            const float m2r = r * r - i * i, m2i = 2.f * r * i, m4r = m2r * m2r - m2i * m2i, m4i = 2.f * m2r * m2i, m8r = m4r * m4r - m4i * m4i, m8i = 2.f * m4r * m4i;
            const float m12r = m8r * m4r - m8i * m4i, m12i = m8r * m4i + m8i * m4r;
            mur[mp] = r; mui[mp] = i; m13r[mp] = m12r; m13i[mp] = m12i;
            const int q = lane >> 4; wqr[mp] = q == 0 ? m12r : (q == 1 ? m8r : (q == 2 ? m4r : 1.f)); wqi[mp] = q == 0 ? m12i : (q == 1 ? m8i : (q == 2 ? m4i : 0.f)); }
        float zr[4] = {0.f, 0.f, 0.f, 0.f}, zi[4] = {0.f, 0.f, 0.f, 0.f};
#pragma unroll 1
        for (int nb = 0; nb < S5_NNB; ++nb) {
            bf16x8 Uf[8];
            const bf16* up = ug + (size_t)(tw + 16 * (16 * nb + (lane & 15))) * 16 + 8 * (lane >> 4);
#pragma unroll
            for (int kb = 0; kb < 8; ++kb) Uf[kb] = __builtin_bit_cast(bf16x8, *(const GAS v4u*)(up + 32 * kb));
            f32x4 acc[8];
#pragma unroll
            for (int mb = 0; mb < 8; ++mb) acc[mb] = (f32x4){0.f, 0.f, 0.f, 0.f};
#pragma unroll
            for (int kb = 0; kb < 8; ++kb)
#pragma unroll
                for (int mb = 0; mb < 8; ++mb) { const bf16x8 Af = *(const LAS bf16x8*)(AP + (16 * mb + (lane & 15)) * S5_APP + 32 * kb + 8 * (lane >> 4)); acc[mb] = MFMA16(Uf[kb], Af, acc[mb]); if (mb == 7) asm volatile("" ::: "memory"); }
#pragma unroll
            for (int mp = 0; mp < 4; ++mp) {
                if (nb > 0) { const float r2 = zr[mp] * m13r[mp] - zi[mp] * m13i[mp], i2 = zr[mp] * m13i[mp] + zi[mp] * m13r[mp]; zr[mp] = r2; zi[mp] = i2; }
#pragma unroll
                for (int r = 0; r < 4; ++r) { const float r2 = zr[mp] * mur[mp] - zi[mp] * mui[mp] + acc[2 * mp][r], i2 = zr[mp] * mui[mp] + zi[mp] * mur[mp] + acc[2 * mp + 1][r]; zr[mp] = r2; zi[mp] = i2; } }
        }
        __syncthreads();
#pragma unroll
        for (int mp = 0; mp < 4; ++mp) { float xr = zr[mp] * wqr[mp] - zi[mp] * wqi[mp], xi = zr[mp] * wqi[mp] + zi[mp] * wqr[mp];
            xr += __shfl_xor(xr, 16); xi += __shfl_xor(xi, 16); xr += __shfl_xor(xr, 32); xi += __shfl_xor(xi, 32);
            if (lane < 16) E[wave * 64 + 16 * mp + lane] = (f32x2v){xr, xi}; }
    }
    __syncthreads();
    float sr = 0.f, si = 0.f;
    for (int w2 = 0; w2 < wave; ++w2) { const f32x2v e = E[w2 * 64 + lane]; const float nsr = pwr * sr - pwi * si + e.x, nsi = pwr * si + pwi * sr + e.y; sr = nsr; si = nsi; }
    bf16x8 Af[8];
#pragma unroll
    for (int mb = 0; mb < 8; ++mb) {
        const int nr_ = 8 * mb + ((lane & 15) >> 1), part = lane & 1; v4u w = (v4u){0u, 0u, 0u, 0u};
        if (lane < 32) { const f32x2v cf = *(const f32x2v*)(S5C + (size_t)(g * 64 + nr_) * 8 + 2);
            const float* pr = a.b_re + (size_t)(g * 64 + nr_) * 16 + 8 * (lane >> 4); const float* pi = a.b_im + (size_t)(g * 64 + nr_) * 16 + 8 * (lane >> 4);
            const f32x4 r0 = *(const f32x4*)pr, r1 = *(const f32x4*)(pr + 4), i0 = *(const f32x4*)pi, i1 = *(const f32x4*)(pi + 4);
            f32x4 v0, v1;
#pragma unroll
            for (int e = 0; e < 4; ++e) { v0[e] = part ? (cf.x * i0[e] + cf.y * r0[e]) : (cf.x * r0[e] - cf.y * i0[e]); v1[e] = part ? (cf.x * i1[e] + cf.y * r1[e]) : (cf.x * r1[e] - cf.y * i1[e]); }
            w.x = pk2(v0[0], v0[1]); w.y = pk2(v0[2], v0[3]); w.z = pk2(v1[0], v1[1]); w.w = pk2(v1[2], v1[3]); }
        Af[mb] = __builtin_bit_cast(bf16x8, w);
    }
    bf16x8 Cf[4];
#pragma unroll
    for (int kb = 0; kb < 4; ++kb) { const int p = lane & 15, n0 = 16 * kb + 4 * (lane >> 4);
        const f32x4 cr4 = *(const f32x4*)(a.c_re + (size_t)(g * 16 + p) * 64 + n0), ci4 = *(const f32x4*)(a.c_im + (size_t)(g * 16 + p) * 64 + n0);
        v4u w; w.x = pk2(cr4[0], -ci4[0]); w.y = pk2(cr4[1], -ci4[1]); w.z = pk2(cr4[2], -ci4[2]); w.w = pk2(cr4[3], -ci4[3]); Cf[kb] = __builtin_bit_cast(bf16x8, w); }
    const f32x4 d4 = *(const f32x4*)(a.s5_d + g * 16 + 4 * (lane >> 4));
    asm volatile("" ::: "memory");
    { v4u R[4];
#pragma unroll
      for (int i = 0; i < 4; ++i) R[i] = useg[lane + 64 * i];
#pragma unroll 1
      for (int ch = 0; ch < S5_NCH; ++ch) {
#pragma unroll
          for (int i = 0; i < 4; ++i) *(LAS v4u*)(Us + 16 * (lane + 64 * i)) = R[i];
          LDS_WAIT(); asm volatile("" ::: "memory");
          const int chn = ch < S5_NCH - 1 ? ch + 1 : ch;
#pragma unroll
          for (int i = 0; i < 4; ++i) R[i] = useg[256 * chn + lane + 64 * i];
#pragma unroll 1
          for (int sb = 0; sb < 8; ++sb) {
              v4u bw = *(const LAS v4u*)(Us + 512 * sb + (lane < 32 ? bf_off : 0)); if (lane >= 32) bw = (v4u){0u, 0u, 0u, 0u};
              const v2u uw = *(const LAS v2u*)(Us + 512 * sb + u4_off);
              s5_sub<true>(Af, Cf, d4, __builtin_bit_cast(bf16x8, bw), uw, sr, si, lbr, lbi, Bu, Sb, YS5 + (size_t)(tw + 128 * ch + 16 * sb) * D + g * 16, lane);
          }
      } }
    p3_stream_items(a, L, (LAS bf16*)(L + wave * S5_WLDS), vcu, G, lane);
    __syncthreads();
}

__device__ __forceinline__ void p3_mem_role(const Args& a, LAS unsigned char* L, int vcu, int G, int wave, int lane) {
    __syncthreads(); __syncthreads(); __syncthreads();
    p3_stream_items(a, L, (LAS bf16*)(L + S5W * S5_WLDS + (wave - S5W) * TR_BYTES), vcu, G, lane);
    __syncthreads();
}
static_assert(S5W * S5_WLDS + (NWAVES - S5W) * TR_BYTES <= S5_E && S5W * S5_WLDS >= 128 * S5_APP * 2, "P3 LDS map: S5 per-wave regions / AP image, then the memory role's transpose scratch, then E");
constexpr size_t WS_BT = 872 * MiB, WS_ACUM = 888 * MiB, WS_CF = 892 * MiB, WS_SC = 1000 * MiB;
static_assert(WS_SC + (size_t)64 * 8 * 128 * 128 * 2 <= WS_H && WS_ACUM + (size_t)M * NH * 4 <= WS_CF && WS_CF + (size_t)64 * 8 * 16384 * 2 <= WS_SC, "ssd scratch map");
constexpr size_t WS_SSQ = 908 * MiB, WS_RT = 916 * MiB;
constexpr int SP_ROW = 136;
__device__ __forceinline__ void ssd_prep_dt(const Args& a, int item, LAS float* tot, int tid) {
    const float* DTP = a.out; float* DTS = (float*)(a.ws + WS_DTS); float* ACUM = (float*)(a.ws + WS_ACUM);
    const int c = item >> 2, h = 32 * (item & 3) + (tid & 31), q = tid >> 5;
    const float av = -expf(a.a_log[h]) * 1.44269504088896f, bias = a.dt_bias[h];
    float raw[8];
#pragma unroll
    for (int i = 0; i < 8; ++i) { const size_t idx = (size_t)(128 * c + 8 * q + i) * NH + h; float r = bias;
#pragma unroll
        for (int ks = 0; ks < 8; ++ks) r += DTP[(size_t)ks * M * NH + idx];
        raw[i] = r; }
    float loc[8]; float run = 0.f;
#pragma unroll
    for (int i = 0; i < 8; ++i) { const float dt = softplus_f(raw[i]); raw[i] = dt; run += dt * av; loc[i] = run; }
    { float* dp = DTS + (size_t)h * M + 128 * c + 8 * q; *(f32x4*)dp = (f32x4){raw[0], raw[1], raw[2], raw[3]}; *(f32x4*)(dp + 4) = (f32x4){raw[4], raw[5], raw[6], raw[7]}; }
    tot[q * 32 + (tid & 31)] = run;
    __syncthreads();
    float off = 0.f;
#pragma unroll
    for (int q2 = 0; q2 < 15; ++q2) off += (q2 < q) ? tot[q2 * 32 + (tid & 31)] : 0.f;
    { float* ap = ACUM + (size_t)h * M + 128 * c + 8 * q; *(f32x4*)ap = (f32x4){loc[0] + off, loc[1] + off, loc[2] + off, loc[3] + off}; *(f32x4*)(ap + 4) = (f32x4){loc[4] + off, loc[5] + off, loc[6] + off, loc[7] + off}; }
    __syncthreads();
}
template <int STAGE> __device__ __forceinline__ void ssd_prep_cg(const Args& a, int c, int g, LAS unsigned char* L, int tid, int wave, int lane) {
    const bf16* XBC = (const bf16*)(a.ws + WS_XBC); bf16* SC = (bf16*)(a.ws + WS_SC) + (size_t)(c * 8 + g) * 16384; bf16* BT = (bf16*)(a.ws + WS_BT) + (size_t)(c * 8 + g) * 16384; bf16* CF = (bf16*)(a.ws + WS_CF) + (size_t)(c * 8 + g) * 16384;
    LAS bf16* Bs = (LAS bf16*)L; LAS bf16* Cs = (LAS bf16*)(L + 128 * SP_ROW * 2);
    const int o = tid & 15;
    if constexpr (STAGE == 0) {
#pragma unroll
    for (int mat = 0; mat < 2; ++mat) {
        const int col0 = DI + mat * (NG * NS) + g * NS + 8 * o;
        f32x4 w0[4], w1[4];
#pragma unroll
        for (int k = 0; k < 4; ++k) { w0[k] = *(const f32x4*)(a.conv_w + k * CONVD + col0); w1[k] = *(const f32x4*)(a.conv_w + k * CONVD + col0 + 4); }
        const f32x4 b0 = *(const f32x4*)(a.conv_b + col0), b1 = *(const f32x4*)(a.conv_b + col0 + 4);
#pragma unroll
        for (int i = 0; i < 4; ++i) { const int tl = (tid >> 4) + 32 * i, t = 128 * c + tl;
            f32x4 acc0 = b0, acc1 = b1;
#pragma unroll
            for (int k = 0; k < 4; ++k) { const int tt = t - 3 + k;
                if (tt >= 0) { f32x4 r0, r1; pg8::unpack8(*(const GAS v4u*)(XBC + (size_t)tt * CONVD + col0), r0, r1); acc0 = acc0 + r0 * w0[k]; acc1 = acc1 + r1 * w1[k]; } }
#pragma unroll
            for (int e = 0; e < 4; ++e) { acc0[e] = pg8::silu_f(acc0[e]); acc1[e] = pg8::silu_f(acc1[e]); }
            v4u ov; ov.x = pk2(acc0.x, acc0.y); ov.y = pk2(acc0.z, acc0.w); ov.z = pk2(acc1.x, acc1.y); ov.w = pk2(acc1.z, acc1.w);
            *(LAS v4u*)((mat ? Cs : Bs) + tl * SP_ROW + 8 * o) = ov; }
    }
    } else {
    { f32x4 acc[8];
#pragma unroll
      for (int sb = 0; sb < 8; ++sb) acc[sb] = (f32x4){0.f, 0.f, 0.f, 0.f};
#pragma unroll
      for (int kb = 0; kb < 4; ++kb) { const bf16x8 cf = *(const LAS bf16x8*)(Cs + (16 * wave + (lane & 15)) * SP_ROW + 32 * kb + 8 * (lane >> 4));
          *(GAS v4u*)(CF + (size_t)((wave * 4 + kb) * 64 + lane) * 8) = __builtin_bit_cast(v4u, cf);
#pragma unroll
          for (int sb = 0; sb < 8; ++sb) { const bf16x8 bfr = *(const LAS bf16x8*)(Bs + (16 * sb + (lane & 15)) * SP_ROW + 32 * kb + 8 * (lane >> 4)); acc[sb] = MFMA16(bfr, cf, acc[sb]); } }
#pragma unroll
      for (int sb = 0; sb < 8; ++sb) { v2u ov; ov.x = pk2(acc[sb][0], acc[sb][1]); ov.y = pk2(acc[sb][2], acc[sb][3]);
          const int q = lane >> 4, lanep = (lane & 15) + 16 * (2 * (sb & 1) + (q >> 1));
          *(GAS v2u*)(SC + (size_t)((wave * 4 + (sb >> 1)) * 64 + lanep) * 8 + 4 * (q & 1)) = ov; } }
#pragma unroll
    for (int kb = 0; kb < 4; ++kb) { unsigned short v[8];
#pragma unroll
        for (int e = 0; e < 8; ++e) v[e] = Bs[(32 * kb + 8 * (lane >> 4) + e) * SP_ROW + 16 * wave + (lane & 15)];
        v4u ov; ov.x = v[0] | ((unsigned)v[1] << 16); ov.y = v[2] | ((unsigned)v[3] << 16); ov.z = v[4] | ((unsigned)v[5] << 16); ov.w = v[6] | ((unsigned)v[7] << 16);
        *(GAS v4u*)(BT + (size_t)((wave * 4 + kb) * 64 + lane) * 8) = ov; }
    }
}
constexpr int PREP_LDS = 2 * 128 * SP_ROW * 2;
constexpr int SM_XD = 0, SM_XW = 8192, SM_XP = 16384, SM_ZP = 24576, SM_AC = 32768, SM_XE = 33280, SM_BUF = 41472, SM_SB = 2 * SM_BUF, SM_SBSZ = 8704;
typedef short s16x4 __attribute__((ext_vector_type(4)));
__device__ __forceinline__ bf16x8 ssd_tr_frag(const LAS unsigned char* img, int kb, int pb, int lane) {
    const LAS unsigned char* ad = img + (32 * kb + 8 * (lane >> 4) + ((lane & 15) >> 2)) * 64 + (16 * pb + 4 * (lane & 3)) * 2;
    const s16x4 lo = __builtin_amdgcn_ds_read_tr16_b64_v4i16((LAS s16x4*)ad), hi = __builtin_amdgcn_ds_read_tr16_b64_v4i16((LAS s16x4*)(ad + 4 * 64));
    return __builtin_shufflevector(lo, hi, 0, 1, 2, 3, 4, 5, 6, 7);
}
__device__ __forceinline__ bf16x8 ssd_tr_frag_y(const LAS unsigned char* img, int kb, int pb, int lane) {
    const LAS unsigned char* ad = img + (32 * kb + 8 * (lane >> 4) + ((lane & 15) >> 2)) * 64 + (8 * (lane & 3) + 4 * pb) * 2;
    const s16x4 lo = __builtin_amdgcn_ds_read_tr16_b64_v4i16((LAS s16x4*)ad), hi = __builtin_amdgcn_ds_read_tr16_b64_v4i16((LAS s16x4*)(ad + 4 * 64));
    return __builtin_shufflevector(lo, hi, 0, 1, 2, 3, 4, 5, 6, 7);
}
struct SsdStage { v4u x, z; float dt, ac, acend, acb; };
__device__ __forceinline__ void ssd_stage_load(SsdStage& s, const bf16* XC, const bf16* MZ, const float* DTS, const float* ACUM, int c, int h, int ph, int tid) {
    const int t = 128 * c + (tid >> 2), piece = tid & 3;
    s.x = *(const GAS v4u*)(XC + (size_t)t * CONVD + h * HD + 32 * ph + 8 * piece);
    s.z = *(const GAS v4u*)(MZ + (size_t)t * DI + h * HD + 32 * ph + 8 * piece);
    s.dt = DTS[(size_t)h * M + t]; s.ac = ACUM[(size_t)h * M + t]; s.acend = ACUM[(size_t)h * M + 128 * c + 127]; s.acb = ACUM[(size_t)h * M + 128 * c + ((tid >> 2) | 31)];
}
__device__ __forceinline__ void ssd_stage_store(const SsdStage& s, LAS unsigned char* buf, int tid) {
    const int tl = tid >> 2, piece = tid & 3;
    const float te = __builtin_amdgcn_exp2f(s.acend - s.ac), tb = __builtin_amdgcn_exp2f(s.acb - s.ac);
    const unsigned xs[4] = {s.x.x, s.x.y, s.x.z, s.x.w}; unsigned d[4], w[4], eb[4];
#pragma unroll
    for (int e2 = 0; e2 < 4; ++e2) { const float x0 = bf_lo(xs[e2]) * s.dt, x1 = bf_hi(xs[e2]) * s.dt; d[e2] = pk2(x0, x1); w[e2] = pk2(x0 * te, x1 * te); eb[e2] = pk2(x0 * tb, x1 * tb); }
    *(LAS v4u*)(buf + SM_XE + tl * 64 + 16 * piece) = (v4u){eb[0], eb[1], eb[2], eb[3]};
    *(LAS v4u*)(buf + SM_XD + tl * 64 + 16 * piece) = (v4u){d[0], d[1], d[2], d[3]};
    *(LAS v4u*)(buf + SM_XW + tl * 64 + 16 * piece) = (v4u){w[0], w[1], w[2], w[3]};
    *(LAS v4u*)(buf + SM_XP + tl * 64 + 16 * piece) = s.x;
    *(LAS v4u*)(buf + SM_ZP + tl * 64 + 16 * piece) = s.z;
    if (piece == 0) *(LAS float*)(buf + SM_AC + 4 * tl) = s.ac;
}
struct SsdFrags { bf16x8 sc[3], scd, cc[4], bt[4]; };
__device__ __forceinline__ void ssd_frag_load(SsdFrags& f, const bf16* SC, const bf16* CF, const bf16* BT, int c, int g, int wave, int lane) {
    const size_t base = ((size_t)((c * 8 + g) * 8 + wave) * 4 * 64 + lane) * 8; const int kd = wave >> 1;
#pragma unroll
    for (int kb = 0; kb < 4; ++kb) { if (kb < 3) { if (kb < kd) f.sc[kb] = __builtin_bit_cast(bf16x8, *(const GAS v4u*)(SC + base + kb * 512)); } else f.scd = __builtin_bit_cast(bf16x8, *(const GAS v4u*)(SC + base + kd * 512));
        f.cc[kb] = __builtin_bit_cast(bf16x8, *(const GAS v4u*)(CF + base + kb * 512)); f.bt[kb] = __builtin_bit_cast(bf16x8, *(const GAS v4u*)(BT + base + kb * 512)); }
}
#define SSD_BAR() do { LDS_WAIT(); asm volatile("" ::: "memory"); __builtin_amdgcn_s_barrier(); asm volatile("" ::: "memory"); } while (0)
template <int DBG> __device__ __forceinline__ void ssd_chunk(const SsdFrags& fr, SsdFrags& frn, const SsdStage& sgs, SsdStage& sgl, f32x4 (&st)[2], int c, int cn, int cl, const bf16* XC, const bf16* MZ, const float* DTS, const float* ACUM, const bf16* SC, const bf16* CF, const bf16* BT, bf16* YSSD, float* SSQ,
                                          int h, int ph, int g, float Dh, LAS unsigned char* L, int tid, int wave, int lane, bool late) {
    LAS unsigned char* buf = L + (c & 1) * SM_BUF; LAS unsigned char* nbuf = L + ((c + 1) & 1) * SM_BUF;
    const LAS bf16* SBo = (const LAS bf16*)(L + SM_SB + (c & 1) * SM_SBSZ); LAS bf16* SBn = (LAS bf16*)(L + SM_SB + ((c + 1) & 1) * SM_SBSZ);
    const LAS unsigned char* XD = buf + SM_XD; const LAS unsigned char* XW = buf + SM_XW; const LAS float* AC = (const LAS float*)(buf + SM_AC);
    if (!(DBG & 2)) ssd_frag_load(frn, SC, CF, BT, cn, g, wave, lane);
    if (!(DBG & 4)) ssd_stage_load(sgl, XC, MZ, DTS, ACUM, cl, h, ph, tid);
    const int trow = 16 * wave + (lane & 15), ko = 8 * (lane >> 4), kd = wave >> 1;
    auto state_and_stage = [&]() __attribute__((always_inline)) {
    { const float dec = __builtin_amdgcn_exp2f(AC[127]); st[0] = st[0] * dec; st[1] = st[1] * dec;
      if (!(DBG & 16))
#pragma unroll
      for (int kb = 0; kb < 4; ++kb)
#pragma unroll
          for (int pb = 0; pb < 2; ++pb) { const bf16x8 Bf = ssd_tr_frag(XW, kb, pb, lane); st[pb] = MFMA16(fr.bt[kb], Bf, st[pb]); }
#pragma unroll
      for (int pb = 0; pb < 2; ++pb) { v2u ov; ov.x = pk2(st[pb][0], st[pb][1]); ov.y = pk2(st[pb][2], st[pb][3]); *(LAS v2u*)(SBn + (16 * pb + (lane & 15)) * SP_ROW + 16 * wave + 4 * (lane >> 4)) = ov; } }
    if (!(DBG & 8)) ssd_stage_store(sgs, nbuf, tid); };
    if (late) state_and_stage();
    const LAS unsigned char* XE = buf + SM_XE;
    bf16x8 Sf[4][2];
#pragma unroll
    for (int kb = 0; kb < 4; ++kb)
#pragma unroll
        for (int pb = 0; pb < 2; ++pb) Sf[kb][pb] = *(const LAS bf16x8*)(SBo + (8 * ((lane & 15) >> 2) + 4 * pb + (lane & 3)) * SP_ROW + 32 * kb + ko);
    const float act = AC[trow];
    const f32x4 as0 = *(const LAS f32x4*)(AC + 32 * kd + ko), as1 = *(const LAS f32x4*)(AC + 32 * kd + ko + 4);
    const float ae0 = AC[31], ae1 = AC[63], ae2 = AC[95];
    const v4u xv = *(const LAS v4u*)(buf + SM_XP + trow * 64 + 16 * (lane >> 4)), zv = *(const LAS v4u*)(buf + SM_ZP + trow * 64 + 16 * (lane >> 4));
    const v2u xw[2] = {(v2u){xv.x, xv.y}, (v2u){xv.z, xv.w}}, zw[2] = {(v2u){zv.x, zv.y}, (v2u){zv.z, zv.w}};
    const f32x4 zero4 = (f32x4){0.f, 0.f, 0.f, 0.f};
    f32x4 accD[2] = {zero4, zero4}, accO[2] = {zero4, zero4}, P[3][2];
    if (!(DBG & 16))
#pragma unroll
    for (int kb = 0; kb < 4; ++kb)
#pragma unroll
        for (int pb = 0; pb < 2; ++pb) accO[pb] = MFMA16(Sf[kb][pb], fr.cc[kb], accO[pb]);
#pragma unroll
    for (int kb = 0; kb < 3; ++kb) if (kb < kd && !(DBG & 16)) {
#pragma unroll
        for (int pb = 0; pb < 2; ++pb) P[kb][pb] = MFMA16(ssd_tr_frag_y(XE, kb, pb, lane), fr.sc[kb], zero4); }
    if (!(DBG & 16)) { const v4u sw = __builtin_bit_cast(v4u, fr.scd); const unsigned sws[4] = {sw.x, sw.y, sw.z, sw.w}; unsigned ow[4];
      const int dl = 16 * (wave & 1) + (lane & 15) - ko;
#pragma unroll
      for (int e2 = 0; e2 < 4; ++e2) { const float a0 = e2 < 2 ? as0[2 * e2] : as1[2 * e2 - 4], a1 = e2 < 2 ? as0[2 * e2 + 1] : as1[2 * e2 - 3];
          float v0 = bf_lo(sws[e2]) * __builtin_amdgcn_exp2f(act - a0), v1 = bf_hi(sws[e2]) * __builtin_amdgcn_exp2f(act - a1);
          v0 = (2 * e2 <= dl) ? v0 : 0.f; v1 = (2 * e2 + 1 <= dl) ? v1 : 0.f;
          ow[e2] = pk2(v0, v1); }
      const bf16x8 Lf = __builtin_bit_cast(bf16x8, ((v4u){ow[0], ow[1], ow[2], ow[3]}));
#pragma unroll
      for (int pb = 0; pb < 2; ++pb) { const bf16x8 Xf = ssd_tr_frag_y(XD, kd, pb, lane); accD[pb] = MFMA16(Xf, Lf, accD[pb]); } }
    { const float ea = __builtin_amdgcn_exp2f(act); float ssq = 0.f;
      const float aes[3] = {ae0, ae1, ae2};
#pragma unroll
      for (int kb = 0; kb < 3; ++kb) if (kb < kd && !(DBG & 16)) { const float r = __builtin_amdgcn_exp2f(act - aes[kb]);
#pragma unroll
          for (int pb = 0; pb < 2; ++pb) accD[pb] = accD[pb] + r * P[kb][pb]; }
      unsigned yo[4];
#pragma unroll
      for (int pb = 0; pb < 2; ++pb) {
          const float y0 = (accD[pb][0] + ea * accO[pb][0] + Dh * bf_lo(xw[pb].x)) * bf_lo(zw[pb].x), y1 = (accD[pb][1] + ea * accO[pb][1] + Dh * bf_hi(xw[pb].x)) * bf_hi(zw[pb].x);
          const float y2 = (accD[pb][2] + ea * accO[pb][2] + Dh * bf_lo(xw[pb].y)) * bf_lo(zw[pb].y), y3 = (accD[pb][3] + ea * accO[pb][3] + Dh * bf_hi(xw[pb].y)) * bf_hi(zw[pb].y);
          ssq += (y0 * y0 + y1 * y1) + (y2 * y2 + y3 * y3);
          yo[2 * pb] = pk2(y0, y1); yo[2 * pb + 1] = pk2(y2, y3); }
      if (!(DBG & 1)) *(GAS v4u*)(YSSD + (size_t)(128 * c + trow) * DI + h * HD + 32 * ph + 8 * (lane >> 4)) = (v4u){yo[0], yo[1], yo[2], yo[3]};
      ssq += __shfl_xor(ssq, 16); ssq += __shfl_xor(ssq, 32);
      if (lane < 16 && !(DBG & 32)) SSQ[((size_t)(8 * c + wave) * 256 + 2 * h + ph) * 16 + lane] = ssq; }
    if (!late) state_and_stage();
    SSD_BAR();
}
template <int DBG> __device__ __forceinline__ void ssd_main_item(const Args& a, int item, LAS unsigned char* L, int tid, int wave, int lane) {
    const bf16* XC = (const bf16*)(a.ws + WS_XC); const bf16* MZ = (const bf16*)(a.ws + WS_MZ); const float* DTS = (const float*)(a.ws + WS_DTS); const float* ACUM = (const float*)(a.ws + WS_ACUM);
    const bf16* SC = (const bf16*)(a.ws + WS_SC); const bf16* BT = (const bf16*)(a.ws + WS_BT); const bf16* CF = (const bf16*)(a.ws + WS_CF); bf16* YSSD = (bf16*)(a.ws + WS_YSSD); float* SSQ = (float*)(a.ws + WS_SSQ);
    const int h = item >> 1, ph = item & 1, g = h >> 4; const float Dh = a.m2_d[h];
    const int wave_hw = wave; wave = wave_hw < 4 ? 7 - wave_hw : wave_hw - 4;
    for (int i = tid; i < SM_SBSZ / 4; i += NWAVES * 64) *(LAS unsigned*)(L + SM_SB + 4 * i) = 0u;
    SsdStage sgE, sgO; SsdFrags frA, frB;
    ssd_stage_load(sgE, XC, MZ, DTS, ACUM, 0, h, ph, tid); ssd_frag_load(frA, SC, CF, BT, 0, g, wave, lane);
    ssd_stage_load(sgO, XC, MZ, DTS, ACUM, 1, h, ph, tid);
    ssd_stage_store(sgE, L, tid);
    f32x4 st[2] = {(f32x4){0.f, 0.f, 0.f, 0.f}, (f32x4){0.f, 0.f, 0.f, 0.f}};
    __syncthreads();
    const bool late = wave_hw >= 4;
#pragma unroll 1
    for (int c = 0; c < 64; c += 2) {
        ssd_chunk<DBG>(frA, frB, sgO, sgE, st, c, c + 1, c + 2 < 64 ? c + 2 : 63, XC, MZ, DTS, ACUM, SC, CF, BT, YSSD, SSQ, h, ph, g, Dh, L, tid, wave, lane, late);
        ssd_chunk<DBG>(frB, frA, sgE, sgO, st, c + 1, c + 2 < 64 ? c + 2 : 63, c + 3 < 64 ? c + 3 : 63, XC, MZ, DTS, ACUM, SC, CF, BT, YSSD, SSQ, h, ph, g, Dh, L, tid, wave, lane, late);
    }
    __syncthreads();
}

__device__ __forceinline__ void ssd_norm_stats(const Args& a, size_t gt, size_t NT) {
    const float* SSQ = (const float*)(a.ws + WS_SSQ); float* RT = (float*)(a.ws + WS_RT);
    for (size_t idx = gt; idx < (size_t)M * NG; idx += NT) {
        const int t = (int)(idx >> 6) * 8 + (int)(idx & 7), g = (int)(idx >> 3) & 7;
        const float* sp = SSQ + ((size_t)(t >> 4) * 256 + 32 * g) * 16 + (t & 15);
        float s = 0.f;
#pragma unroll 8
        for (int j = 0; j < 32; ++j) s += sp[j * 16];
        const float r = 1.0f / sqrtf(s * (1.0f / 1024.0f) + EPS);
        const float rn = __shfl_down(r, 8);
        RT[(size_t)t * 8 + g] = (g == 7) ? r : r / rn;
    }
}
__global__ void __launch_bounds__(NWAVES * 64, 2) hyb_fwd(Args args) {
    extern __shared__ __attribute__((aligned(16))) unsigned char lds[];
    LAS unsigned char* L = (LAS unsigned char*)lds;
    volatile LAS unsigned* MISC = (volatile LAS unsigned*)(L + MISC_OFF);
    const int tid = threadIdx.x, lane = tid & 63, wave = __builtin_amdgcn_readfirstlane(tid >> 6);
    const int G = gridDim.x; const int bx = blockIdx.x; const int vcu = (G % 8 == 0) ? (bx % 8) * (G / 8) + bx / 8 : bx;
    const int gw = vcu * NWAVES + wave, NGW = G * NWAVES;
    gu32* ctl = (gu32*)(args.ws + WS_CTL);
    for (int u = tid; u < (LDS_BYTES - LDSCTL_OFF) / 4; u += NWAVES * 64) ((LAS unsigned*)(L + LDSCTL_OFF))[u] = 0u;
    __syncthreads();
    XcdBarrier bar; bar.bar = (unsigned*)(ctl + CW_BAR); bar.x = 0; bar.st = nullptr;
    if (N_LAUNCHES == 1) bar = xcd_barrier_post((unsigned*)(ctl + CW_BAR), MISC + 8);
#define GRID_BAR() do { if (N_LAUNCHES == 1) xcd_barrier(bar); } while (0)
    const int lo = args.ph_lo, hi = args.ph_hi;
#define IN(k) (lo <= (k) && (k) < hi)
#define BOTH(k) (IN(k) && IN((k) + 1))
#if defined(PROBE_PHASE)
#define PROBE_DBG(x) (x)
#else
#define PROBE_DBG(x) 0
#endif
#define LAUNDER() int lane_p = lane, tid_p = tid; asm volatile("" : "+v"(lane_p), "+v"(tid_p))

    if (IN(0)) {
        LAUNDER();
        p0_gemv(args.c, args.w_ada, (float*)(args.ws + WS_MODP), (LAS float*)(L + RING_OFF), vcu, G, tid_p);
        p0_weights_in(args, (LAS bf16*)(L + RING_OFF + wave * 16384), gw, NGW, lane_p);
        s5_consts(args, (size_t)gw * 64 + lane_p, (size_t)NGW * 64);
        if (BOTH(0)) GRID_BAR();
    }
    if (IN(1)) {
        LAUNDER();
        p1_h(args, (LAS float*)(L + RING_OFF), (LAS float*)(L + RING_OFF + 16384), gw, NGW, tid_p, lane_p);
        if (BOTH(1)) GRID_BAR();
    }
    if (IN(2)) {
        { pg8::Gemm g{(const bf16*)(args.ws + WS_H), (const bf16*)(args.ws + WS_WIN), M, NMAIN, D, D}; pg8::StaticOrder S; S.init(M, NMAIN, G, bx);
          pg8::EpiProj E{(bf16*)(args.ws + WS_U), (bf16*)(args.ws + WS_SZ), (bf16*)(args.ws + WS_MZ), (bf16*)(args.ws + WS_XBC), (bf16*)(args.ws + WS_G1), (bf16*)(args.ws + WS_G2)};
          pg8::gemm_phase<pg8::EpiProj, pg8::StaticOrder, PG8_ALIGN, PG8_SP2>(L + RING_OFF, g, S, E); }
        { pg8::Gemm g{(const bf16*)(args.ws + WS_H), (const bf16*)(args.ws + WS_WIN) + (size_t)NMAIN * D, M, 8 * 256, 512, D}; pg8::StaticOrder S; S.init(M, 8 * 256, G, bx);
          pg8::EpiDTP E{args.out};
          pg8::gemm_phase<pg8::EpiDTP, pg8::StaticOrder, PG8_ALIGN, PG8_SP2, true>(L + RING_OFF, g, S, E); }
        if (BOTH(2)) GRID_BAR();
    }
    if (IN(3)) {
        LAUNDER();
        const int sub = args.sub;
        if (tid_p == 0) *(LAS unsigned*)(L + RING_OFF + P3_CNT_OFF) = (sub == 5) ? 0x100000u : 0u;
        if (sub == 0 || sub == 2) for (int it = vcu; it < 64 * NG; it += 2 * G) {
            const int it2 = it + G; const bool two = it2 < 64 * NG;
            ssd_prep_cg<0>(args, it >> 3, it & 7, L + RING_OFF, tid_p, wave, lane_p);
            if (two) ssd_prep_cg<0>(args, it2 >> 3, it2 & 7, L + RING_OFF + PREP_LDS, tid_p, wave, lane_p);
            __syncthreads();
            ssd_prep_cg<1>(args, it >> 3, it & 7, L + RING_OFF, tid_p, wave, lane_p);
            if (two) ssd_prep_cg<1>(args, it2 >> 3, it2 & 7, L + RING_OFF + PREP_LDS, tid_p, wave, lane_p);
            __syncthreads(); }
        if (sub == 0 || sub == 3) for (int it = vcu; it < 64 * 4; it += G) ssd_prep_dt(args, it, (LAS float*)(L + RING_OFF), tid_p);
        if (sub == 0 || sub == 1 || sub == 5) for (int g5 = vcu; g5 < S5G; g5 += G) {
            if (wave < S5W) s5_fast_group(args, g5, L + RING_OFF, vcu, G, wave, lane_p);
            else p3_mem_role(args, L + RING_OFF, vcu, G, wave, lane_p); }
        if (BOTH(3)) GRID_BAR();
    }
    if (IN(4)) { LAUNDER(); for (int it = vcu; it < NH * 2; it += G) {
#if defined(PROBE_PHASE) && PROBE_PHASE == 4
            if (args.sub) ssd_main_item<PROBE_SUB>(args, it, L + RING_OFF, tid_p, wave, lane_p); else
#endif
            ssd_main_item<0>(args, it, L + RING_OFF, tid_p, wave, lane_p); } if (BOTH(4)) GRID_BAR(); }
    if (IN(5)) { LAUNDER(); ssd_norm_stats(args, (size_t)gw * 64 + lane_p, (size_t)NGW * 64); }
    if (IN(6)) {
        pg8::Gemm g{(const bf16*)(args.ws + WS_YS5), (const bf16*)(args.ws + WS_WGLU), M, 8192, D, D}; pg8::StaticOrder S; S.init(M, 8192, G, bx);
        pg8::EpiGlu E{(const bf16*)(args.ws + WS_SZ), args.b_glu, (bf16*)(args.ws + WS_YS5G)};
        pg8::gemm_phase<pg8::EpiGlu, pg8::StaticOrder, PG8_ALIGN, PG8_SP2>(L + RING_OFF, g, S, E);
        if (BOTH(6)) GRID_BAR();
    }
    if (IN(7)) {
        pg8::Gemm g{(const bf16*)(args.ws + WS_YS5G), (const bf16*)(args.ws + WS_WBRS), M, D, D, D}; pg8::StaticOrder S; S.init(M, D, G, bx);
        pg8::EpiBrS E{(const bf16*)(args.ws + WS_G1), (bf16*)(args.ws + WS_T1)};
        pg8::gemm_phase<pg8::EpiBrS, pg8::StaticOrder, PG8_ALIGN, PG8_SP2>(L + RING_OFF, g, S, E);
    }
    if (IN(8)) {
        pg8::Gemm g{(const bf16*)(args.ws + WS_YSSD), (const bf16*)(args.ws + WS_WBRM), M, D, DI, DI}; pg8::StaticOrder S; S.init(M, D, G, bx);
        pg8::EpiBrM E{(const bf16*)(args.ws + WS_G2), (const bf16*)(args.ws + WS_T1), (bf16*)(args.ws + WS_MERGED), (const float*)(args.ws + WS_RT)};
        pg8::gemm_phase<pg8::EpiBrM, pg8::StaticOrder, PG8_ALIGN, PG8_SP2>(L + RING_OFF, g, S, E);
        if (BOTH(8)) GRID_BAR();
    }
    if (IN(9)) {
        pg8::Gemm g{(const bf16*)(args.ws + WS_MERGED), (const bf16*)(args.ws + WS_WOUT), M, D, D, D}; pg8::StaticOrder S; S.init(M, D, G, bx);
        pg8::EpiOut E{args.x, (const float*)(args.ws + WS_GATE), (bf16*)(args.ws + WS_X2), (float*)(args.ws + WS_SS)};
        pg8::gemm_phase<pg8::EpiOut, pg8::StaticOrder, PG8_ALIGN, PG8_SP2>(L + RING_OFF, g, S, E);
        if (BOTH(9)) GRID_BAR();
    }
    if (IN(10)) { LAUNDER(); final_norm(args, gw, NGW, lane_p); }

#if defined(DBG_STOP)
    if (IN(NPH)) {
        const size_t gt = (size_t)gw * 64 + lane, NT = (size_t)NGW * 64; const size_t R = (size_t)8 << 20;
        const unsigned char* b0 = args.ws + DBG_B0; const unsigned char* b1 = args.ws + DBG_B1; const unsigned char* b2 = args.ws + DBG_B2; const unsigned char* b3 = args.ws + DBG_B3;
        for (size_t i = gt; i < R; i += NT) {
            float s0 = 0.f, s1 = 0.f, s2 = 0.f, s3 = 0.f;
            for (size_t j = i; j < (size_t)DBG_N0; j += R) s0 += DBG_F0 ? ((const float*)b0)[j] : bf2f(((const bf16*)b0)[j]);
            for (size_t j = i; j < (size_t)DBG_N1; j += R) s1 += DBG_F1 ? ((const float*)b1)[j] : bf2f(((const bf16*)b1)[j]);
            for (size_t j = i; j < (size_t)DBG_N2; j += R) s2 += DBG_F2 ? ((const float*)b2)[j] : bf2f(((const bf16*)b2)[j]);
            for (size_t j = i; j < (size_t)DBG_N3; j += R) s3 += DBG_F3 ? ((const float*)b3)[j] : bf2f(((const bf16*)b3)[j]);
            args.out[i] = s0 * 1e9f; args.out[R + i] = s1 * 1e6f; args.out[2 * R + i] = s2 * 1e3f; args.out[3 * R + i] = s3;
        }
    }
#endif
#undef IN
#undef BOTH
}

extern "C" void kernel_launch(void* const* d_in, const int* in_sizes, int n_in, void* d_out, int out_size, void* d_ws, size_t ws_size, hipStream_t stream) {
    static int grid = 0;
    if (grid == 0) {
        if (n_in != 26 || in_sizes[0] != M * D || out_size != M * D || ws_size < WS_END) { fprintf(stderr, "kernel_launch: built for 26 inputs, x/out of %d floats, >= %zu bytes of workspace; got n_in %d, in0 %d, out %d, ws %zu; nothing launched\n", M * D, (size_t)WS_END, n_in, n_in > 0 ? in_sizes[0] : -1, out_size, ws_size); grid = -1; return; }
        int dev = 0, cus = 0, per_cu = 0;
        if (hipGetDevice(&dev) != hipSuccess || hipDeviceGetAttribute(&cus, hipDeviceAttributeMultiprocessorCount, dev) != hipSuccess) { fprintf(stderr, "kernel_launch: hipGetDevice / hipDeviceGetAttribute failed\n"); grid = -1; return; }
        if (hipFuncSetAttribute((const void*)hyb_fwd, hipFuncAttributeMaxDynamicSharedMemorySize, LDS_BYTES) != hipSuccess) { fprintf(stderr, "kernel_launch: hipFuncSetAttribute failed\n"); grid = -1; return; }
        if (hipOccupancyMaxActiveBlocksPerMultiprocessor(&per_cu, (const void*)hyb_fwd, NWAVES * 64, LDS_BYTES) != hipSuccess || per_cu < 1)
            fprintf(stderr, "kernel_launch: note: the occupancy query reports %d workgroups per CU\n", per_cu);
        (void)hipGetLastError();
        grid = cus;
    }
    if (grid < 0) return;
    if (hipMemsetAsync((char*)d_ws + WS_CTL, 0, CTL_ZERO_BYTES, stream) != hipSuccess) { fprintf(stderr, "kernel_launch: hipMemsetAsync failed\n"); return; }
    Args a{};
    const float** ap = (const float**)&a;
    for (int i = 0; i < 26; ++i) ap[i] = (const float*)d_in[i];
    a.out = (float*)d_out; a.ws = (unsigned char*)d_ws;
#if defined(DBG_STOP)
    const int nl = DBG_STOP + 2;
#else
    const int nl = N_LAUNCHES;
#endif
    for (int li = 0; li < nl; ++li) {
        a.ph_lo = (N_LAUNCHES == 1) ? 0 : li; a.ph_hi = (N_LAUNCHES == 1) ? NPH : li + 1;
#if defined(DBG_STOP)
        if (li == nl - 1) { a.ph_lo = NPH; a.ph_hi = NPH + 1; }
#endif
        hipLaunchKernelGGL(hyb_fwd, dim3(grid), dim3(NWAVES * 64), LDS_BYTES, stream, a);
        const hipError_t le = hipPeekAtLastError();
        if (le != hipSuccess) { fprintf(stderr, "kernel_launch: launch %d failed: %s\n", li, hipGetErrorName(le)); break; }
    }
#if defined(PROBE_PHASE)
    a.ph_lo = PROBE_PHASE; a.ph_hi = PROBE_PHASE + 1; a.sub = PROBE_SUB;
    hipLaunchKernelGGL(hyb_fwd, dim3(grid), dim3(NWAVES * 64), LDS_BYTES, stream, a);
#endif
}
```

```cpp
#include <hip/hip_runtime.h>
#include <cstdio>
#include <cstdint>
namespace pg8 {
#define PG8_LAS __attribute__((address_space(3)))
typedef unsigned short bf16_t;
typedef short bf16x8 __attribute__((ext_vector_type(8)));
typedef float f32x4 __attribute__((ext_vector_type(4)));
typedef unsigned u32x4 __attribute__((ext_vector_type(4)));
constexpr int BM = 256, BK = 64, HALF = 128, HTB = HALF * BK * 2  , STAGE_BYTES = 8 * HTB, NXCD = 8, WGM = 4;

__host__ __device__ __forceinline__ int lds_byte(int r, int c) { const int st = (r >> 4) * 2 + (c >> 5), rr = r & 15, cc = c & 31, ob = rr * 64 + cc * 2; return st * 1024 + (ob ^ (((ob >> 9) & 1) << 5)); }
__host__ __device__ __forceinline__ void stage_rc(int b, int& R, int& C) { const int st = b / 1024, sb = b % 1024, swz = sb ^ (((sb >> 9) & 1) << 5); R = (st >> 1) * 16 + swz / 64; C = (st & 1) * 32 + (swz % 64) / 2; }
__host__ __device__ __forceinline__ int perm32(int rho) { const int n = rho >> 4, i = rho & 15; return 8 * (i >> 2) + 4 * n + (i & 3); }

struct Unit { int pm, pn; };
struct Gemm { const bf16_t* A; const bf16_t* Bt; int M, N, K, ld; };

struct StaticOrder {
    int nM, nN, nwg, G, c;
    __host__ __device__ void init(int M, int N, int G_, int c_) { nM = M / BM; nN = N / BM; nwg = nM * nN; G = G_; c = c_; }
    __host__ __device__ bool next(int i, Unit& u) const {
        const long L = (long)i * G + c; if (L >= nwg) return false;
        int wgid = (int)L; { const int q = nwg / NXCD, r = nwg % NXCD, xcd = wgid % NXCD, off = wgid / NXCD; wgid = (xcd < r ? xcd * (q + 1) : r * (q + 1) + (xcd - r) * q) + off; }
        const int nig = WGM * nN, gid = wgid / nig, fm = gid * WGM, gsz = (nM - fm) < WGM ? (nM - fm) : WGM;
        u.pm = fm + ((wgid % nig) % gsz); u.pn = (wgid % nig) / gsz; return true;
    }
    __device__ __forceinline__ void a_ready(const Unit&) const {}
    __device__ __forceinline__ void done(const Unit&) const {}
};
typedef float f32x2c_ __attribute__((ext_vector_type(2)));
typedef __bf16 bf16x2c_ __attribute__((ext_vector_type(2)));
__device__ __forceinline__ unsigned cvt_pk_bf16(float lo, float hi) { return __builtin_bit_cast(unsigned, __builtin_convertvector(((f32x2c_){lo, hi}), bf16x2c_)); }
#define EPI_MFMA_SETTLE() do {} while (0)
__device__ __forceinline__ float bf_lo(unsigned w) { return __builtin_bit_cast(float, w << 16); }
__device__ __forceinline__ float bf_hi(unsigned w) { return __builtin_bit_cast(float, w & 0xffff0000u); }
__device__ __forceinline__ float sigmoid_f(float v) { return __builtin_amdgcn_rcpf(1.0f + __expf(-v)); }
__device__ __forceinline__ float silu_f(float v) { return v * sigmoid_f(v); }
template <int ACT> __device__ __forceinline__ float act_f(float v) { if (ACT == 1) return silu_f(v); if (ACT == 2) return sigmoid_f(v); return v; }
__device__ __forceinline__ u32x4 pack8(const f32x4& v0, const f32x4& v1) { u32x4 w; w.x = cvt_pk_bf16(v0[0], v0[1]); w.y = cvt_pk_bf16(v0[2], v0[3]); w.z = cvt_pk_bf16(v1[0], v1[1]); w.w = cvt_pk_bf16(v1[2], v1[3]); return w; }
__device__ __forceinline__ void unpack8(const u32x4 w, f32x4& v0, f32x4& v1) { v0 = (f32x4){bf_lo(w.x), bf_hi(w.x), bf_lo(w.y), bf_hi(w.y)}; v1 = (f32x4){bf_lo(w.z), bf_hi(w.z), bf_lo(w.w), bf_hi(w.w)}; }

struct EpiProj {
    static constexpr bool PERM = true, AFTER_DRAIN = false, KHOOK = false;
    bf16_t *U, *SZ, *MZ, *XBC, *G1, *G2;
    template <int ACT> __device__ __forceinline__ void store_tile(const f32x4 (&acc)[2][2][4][2], bf16_t* base, size_t rs, size_t bs, int row0) const {
#pragma unroll
        for (int ai = 0; ai < 2; ++ai)
#pragma unroll
            for (int m = 0; m < 4; ++m) { bf16_t* rowp = base + (size_t)(row0 + ai * HALF + m * 16) * rs;
#pragma unroll
                for (int bj = 0; bj < 2; ++bj) { f32x4 v0 = acc[ai][bj][m][0], v1 = acc[ai][bj][m][1];
#pragma unroll
                    for (int e = 0; e < 4; ++e) { v0[e] = act_f<ACT>(v0[e]); v1[e] = act_f<ACT>(v1[e]); }
                    __builtin_nontemporal_store(pack8(v0, v1), (u32x4*)(rowp + bj * bs)); } }
    }
    __device__ __forceinline__ void operator()(const f32x4 (&acc)[2][2][4][2], const Unit& u, int wr, int wc, int fr, int fq) const {
        EPI_MFMA_SETTLE();
        const int pn = u.pn, row0 = u.pm * BM + wr * 64 + fr, cl = wc * 32 + 8 * fq;
        if (pn < 16) {
            const int col = pn * BM + cl; store_tile<0>(acc, U + (size_t)(col >> 4) * (8192 * 16) + (col & 15), 16, (size_t)8 * 8192 * 16, row0);
        } else if (pn < 32) {
            store_tile<1>(acc, SZ + (pn - 16) * BM + cl, 4096, HALF, row0);
        } else if (pn < 64) {
            store_tile<1>(acc, MZ + (pn - 32) * BM + cl, 8192, HALF, row0);
        } else if (pn < 104) {
            store_tile<0>(acc, XBC + (pn - 64) * BM + cl, 10240, HALF, row0);
        } else if (pn < 120) {
            store_tile<2>(acc, G1 + (pn - 104) * BM + cl, 4096, HALF, row0);
        } else {
            store_tile<2>(acc, G2 + (pn - 120) * BM + cl, 4096, HALF, row0);
        }
    }
};
struct EpiDTP {
    static constexpr bool PERM = true, AFTER_DRAIN = false, KHOOK = false;
    float* DTP;
    __device__ __forceinline__ void operator()(const f32x4 (&acc)[2][2][4][2], const Unit& u, int wr, int wc, int fr, int fq) const {
        const int row0 = u.pm * BM + wr * 64 + fr, cl = wc * 32 + 8 * fq;
#pragma unroll
        for (int ai = 0; ai < 2; ++ai)
#pragma unroll
            for (int m = 0; m < 4; ++m) { float* rowp = DTP + ((size_t)u.pn * 8192 + row0 + ai * HALF + m * 16) * 128 + cl;
                *(f32x4*)(rowp) = acc[ai][0][m][0]; *(f32x4*)(rowp + 4) = acc[ai][0][m][1]; }
    }
};
struct EpiGlu {
    static constexpr bool PERM = true, AFTER_DRAIN = false, KHOOK = false;
    const bf16_t* SZ; const float* bias; bf16_t* O;
    __device__ __forceinline__ void operator()(const f32x4 (&acc)[2][2][4][2], const Unit& u, int wr, int wc, int fr, int fq) const {
        EPI_MFMA_SETTLE();
        const int row0 = u.pm * BM + wr * 64 + fr, j0 = u.pn * HALF + wc * 32 + 8 * fq;
        const f32x4 ba0 = *(const f32x4*)(bias + j0), ba1 = *(const f32x4*)(bias + j0 + 4), bb0 = *(const f32x4*)(bias + 4096 + j0), bb1 = *(const f32x4*)(bias + 4096 + j0 + 4);
        u32x4 zr[8];
#pragma unroll
        for (int i = 0; i < 8; ++i) zr[i] = *(const u32x4*)(SZ + (size_t)(row0 + (i >> 2) * HALF + (i & 3) * 16) * 4096 + j0);
#pragma unroll
        for (int ai = 0; ai < 2; ++ai)
#pragma unroll
            for (int m = 0; m < 4; ++m) { const size_t off = (size_t)(row0 + ai * HALF + m * 16) * 4096 + j0;
                f32x4 z0, z1; unpack8(zr[ai * 4 + m], z0, z1);
                f32x4 a0 = acc[ai][0][m][0] + ba0, a1 = acc[ai][0][m][1] + ba1, b0 = acc[ai][1][m][0] + bb0, b1 = acc[ai][1][m][1] + bb1;
#pragma unroll
                for (int e = 0; e < 4; ++e) { a0[e] = a0[e] * sigmoid_f(b0[e]) * z0[e]; a1[e] = a1[e] * sigmoid_f(b1[e]) * z1[e]; }
                *(u32x4*)(O + off) = pack8(a0, a1); }
    }
};
struct EpiBrS {
    static constexpr bool PERM = true, AFTER_DRAIN = false, KHOOK = false;
    const bf16_t* G1; bf16_t* T1;
    __device__ __forceinline__ void operator()(const f32x4 (&acc)[2][2][4][2], const Unit& u, int wr, int wc, int fr, int fq) const {
        EPI_MFMA_SETTLE();
        const int row0 = u.pm * BM + wr * 64 + fr, c0 = u.pn * BM + wc * 32 + 8 * fq;
#pragma unroll
        for (int ai = 0; ai < 2; ++ai) { u32x4 gr[8];
#pragma unroll
            for (int i = 0; i < 8; ++i) gr[i] = *(const u32x4*)(G1 + (size_t)(row0 + ai * HALF + (i >> 1) * 16) * 4096 + c0 + (i & 1) * HALF);
#pragma unroll
            for (int m = 0; m < 4; ++m)
#pragma unroll
                for (int bj = 0; bj < 2; ++bj) { const size_t off = (size_t)(row0 + ai * HALF + m * 16) * 4096 + c0 + bj * HALF;
                    f32x4 g0, g1; unpack8(gr[m * 2 + bj], g0, g1);
                    *(u32x4*)(T1 + off) = pack8(acc[ai][bj][m][0] * g0, acc[ai][bj][m][1] * g1); } }
    }
};
struct EpiBrM {
    static constexpr bool PERM = true, AFTER_DRAIN = false, KHOOK = true;
    const bf16_t* G2; const bf16_t* T1; bf16_t* O; const float* RT;
    __device__ __forceinline__ void unit_begin(const Unit& u, PG8_LAS unsigned char* tbl, int tid) const {
        const f32x4 v = *(const f32x4*)(RT + (size_t)u.pm * BM * 8 + 4 * tid); *(PG8_LAS f32x4*)(tbl + 16 * tid) = v;
    }
    __device__ __forceinline__ void khook(f32x4 (&acc)[2][2][4][2], const PG8_LAS unsigned char* tbl, int g, int wr, int fr) const {
#pragma unroll
        for (int ai = 0; ai < 2; ++ai)
#pragma unroll
            for (int m = 0; m < 4; ++m) { const float f = *(const PG8_LAS float*)(tbl + ((ai * HALF + wr * 64 + m * 16 + fr) * 8 + g) * 4);
#pragma unroll
                for (int bj = 0; bj < 2; ++bj)
#pragma unroll
                    for (int n = 0; n < 2; ++n) acc[ai][bj][m][n] = acc[ai][bj][m][n] * f; }
    }
    __device__ __forceinline__ void epi(const f32x4 (&acc)[2][2][4][2], const Unit& u, int wr, int wc, int fr, int fq, const PG8_LAS unsigned char* tbl) const {
        const int row0 = u.pm * BM + wr * 64 + fr, c0 = u.pn * BM + wc * 32 + 8 * fq;
#pragma unroll
        for (int ai = 0; ai < 2; ++ai) { u32x4 gr[8], tr[8];
#pragma unroll
            for (int i = 0; i < 8; ++i) { const size_t off = (size_t)(row0 + ai * HALF + (i >> 1) * 16) * 4096 + c0 + (i & 1) * HALF; gr[i] = *(const u32x4*)(G2 + off); tr[i] = *(const u32x4*)(T1 + off); }
#pragma unroll
            for (int m = 0; m < 4; ++m) { const float f = *(const PG8_LAS float*)(tbl + ((ai * HALF + wr * 64 + m * 16 + fr) * 8 + 7) * 4);
#pragma unroll
                for (int bj = 0; bj < 2; ++bj) { const size_t off = (size_t)(row0 + ai * HALF + m * 16) * 4096 + c0 + bj * HALF;
                    f32x4 g0, g1; unpack8(gr[m * 2 + bj], g0, g1);
                    f32x4 t0, t1; unpack8(tr[m * 2 + bj], t0, t1);
                    *(u32x4*)(O + off) = pack8(t0 + acc[ai][bj][m][0] * (g0 * f), t1 + acc[ai][bj][m][1] * (g1 * f)); } } }
    }
};
struct EpiOut {
    static constexpr bool PERM = true, AFTER_DRAIN = false, KHOOK = false;
    const float* X; const float* gate; bf16_t* O; float* SS;
    __device__ __forceinline__ void operator()(const f32x4 (&acc)[2][2][4][2], const Unit& u, int wr, int wc, int fr, int fq) const {
        EPI_MFMA_SETTLE();
        const int row0 = u.pm * BM + wr * 64 + fr, c0 = u.pn * BM + wc * 32 + 8 * fq;
        f32x4 gv[2][2];
#pragma unroll
        for (int bj = 0; bj < 2; ++bj) { gv[bj][0] = *(const f32x4*)(gate + c0 + bj * HALF); gv[bj][1] = *(const f32x4*)(gate + c0 + bj * HALF + 4); }
#pragma unroll
        for (int ai = 0; ai < 2; ++ai)
#pragma unroll
            for (int mh = 0; mh < 2; ++mh) { f32x4 xr[8];
#pragma unroll
                for (int i = 0; i < 8; ++i) xr[i] = *(const f32x4*)(X + (size_t)(row0 + ai * HALF + (2 * mh + (i >> 2)) * 16) * 4096 + c0 + ((i >> 1) & 1) * HALF + 4 * (i & 1));
#pragma unroll
                for (int mm = 0; mm < 2; ++mm) { const int m = 2 * mh + mm, row = row0 + ai * HALF + m * 16; float s = 0.f;
#pragma unroll
                    for (int bj = 0; bj < 2; ++bj) { const size_t off = (size_t)row * 4096 + c0 + bj * HALF;
                        const f32x4 o0 = xr[mm * 4 + bj * 2] + acc[ai][bj][m][0] * gv[bj][0], o1 = xr[mm * 4 + bj * 2 + 1] + acc[ai][bj][m][1] * gv[bj][1];
                        *(u32x4*)(O + off) = pack8(o0, o1);
                        s += (o0[0] * o0[0] + o0[1] * o0[1]) + (o0[2] * o0[2] + o0[3] * o0[3]) + (o1[0] * o1[0] + o1[1] * o1[1]) + (o1[2] * o1[2] + o1[3] * o1[3]); }
                    s += __shfl_xor(s, 16); s += __shfl_xor(s, 32);
                    if (fq == 0) SS[(size_t)row * 64 + u.pn * 4 + wc] = s; } }
    }
};
template <class Epi, class Sched, bool ALIGN_EPI = false, bool SP2 = false, bool SPLITK = false>
__device__ __forceinline__ void gemm_phase(PG8_LAS unsigned char* lds, const Gemm g, const Sched& S, const Epi& E) {
    const int tid = threadIdx.x, wid = __builtin_amdgcn_readfirstlane(tid >> 6), lane = tid & 63, wr = wid >> 2, wc = wid & 3, fr = lane & 15, fq = lane >> 4;
    const int K = g.K, nt = K / BK, LD = g.ld;
    unsigned voffA[2], voffB[2];
#pragma unroll
    for (int i = 0; i < 2; ++i) { int R, C; stage_rc(tid * 16 + i * 8192, R, C); const int Rb = Epi::PERM ? ((R & ~31) + perm32(R & 31)) : R;
        voffA[i] = (unsigned)(R * LD + C) * 2u; voffB[i] = (unsigned)(Rb * LD + C) * 2u; }
    const size_t kstep = (size_t)(BK * 2);
    const size_t hstep = (size_t)HALF * LD * 2;
    const size_t tstep = 2 * hstep;
    const unsigned ldsw = (unsigned)wid * 1024u;
    const int aoff = lds_byte(wr * 64 + fr, fq * 8), boff = lds_byte(wc * 32 + fr, fq * 8);
#define PG8_SA(b, h) (((b) * 2 + (h)) * HTB)
#define PG8_SB(b, h) ((4 + (b) * 2 + (h)) * HTB)
#define PG8_STAGE(bufoff, gbase, voff) do { _Pragma("unroll") for (int _i = 0; _i < 2; ++_i) \
        __builtin_amdgcn_global_load_lds((const unsigned*)((const char*)(gbase) + (voff)[_i]), (PG8_LAS unsigned*)(lds + (bufoff) + ldsw + _i * 8192), 16, 0, 0); } while (0)
#define PG8_LDA(dst, b, h) do { _Pragma("unroll") for (int m = 0; m < 4; ++m) _Pragma("unroll") for (int k = 0; k < 2; ++k) dst[m][k] = *(const PG8_LAS bf16x8*)(lds + PG8_SA(b, h) + aoff + m * 2048 + k * 1024); } while (0)
#define PG8_LDB(dst, b, h) do { _Pragma("unroll") for (int n = 0; n < 2; ++n) _Pragma("unroll") for (int k = 0; k < 2; ++k) dst[n][k] = *(const PG8_LAS bf16x8*)(lds + PG8_SB(b, h) + boff + n * 2048 + k * 1024); } while (0)
#define PG8_MMA(ai, bj, At, Bt) do { __builtin_amdgcn_s_setprio(1); _Pragma("unroll") for (int m = 0; m < 4; ++m) _Pragma("unroll") for (int n = 0; n < 2; ++n) _Pragma("unroll") for (int k = 0; k < 2; ++k) \
        acc[ai][bj][m][n] = __builtin_amdgcn_mfma_f32_16x16x32_bf16(Bt[n][k], At[m][k], acc[ai][bj][m][n], 0, 0, 0); __builtin_amdgcn_s_setprio(0); } while (0)
#define PG8_WAIT_V(n) asm volatile("s_waitcnt vmcnt(" #n ")" ::: "memory")
#define PG8_WAIT_L(n) asm volatile("s_waitcnt lgkmcnt(" #n ")" ::: "memory")
#define PG8_BAR __builtin_amdgcn_s_barrier()
#define PG8_SCHED __builtin_amdgcn_sched_barrier(0)
    Unit cur, nxt; int ui = 0;
    if (!S.next(0, cur)) return;
    f32x4 acc[2][2][4][2];
#pragma unroll
    for (int a = 0; a < 2; ++a)
#pragma unroll
        for (int b = 0; b < 2; ++b)
#pragma unroll
            for (int m = 0; m < 4; ++m)
#pragma unroll
                for (int n = 0; n < 2; ++n) acc[a][b][m][n] = (f32x4){0.f, 0.f, 0.f, 0.f};
    bf16x8 At[4][2], B0[2][2], B1[2][2];
    const char* cA = (const char*)g.A + (size_t)cur.pm * tstep + (SPLITK ? (size_t)cur.pn * K * 2 : (size_t)0); const char* cB = (const char*)g.Bt + (SPLITK ? (size_t)cur.pn * K * 2 : (size_t)cur.pn * tstep);
    S.a_ready(cur);
    if constexpr (SP2) {
        PG8_STAGE(PG8_SB(0, 0), cB, voffB); PG8_STAGE(PG8_SB(0, 1), cB + hstep, voffB); PG8_STAGE(PG8_SA(0, 0), cA, voffA); PG8_STAGE(PG8_SA(0, 1), cA + hstep, voffA);
        if (wr == 1) PG8_BAR;
        PG8_WAIT_V(2); PG8_BAR;
        PG8_STAGE(PG8_SB(1, 0), cB + kstep, voffB); PG8_STAGE(PG8_SA(1, 0), cA + kstep, voffA); PG8_STAGE(PG8_SB(1, 1), cB + hstep + kstep, voffB);
        PG8_WAIT_V(6); PG8_BAR;
    } else {
        PG8_STAGE(PG8_SB(0, 0), cB, voffB); PG8_STAGE(PG8_SA(0, 0), cA, voffA); PG8_STAGE(PG8_SB(0, 1), cB + hstep, voffB); PG8_STAGE(PG8_SA(0, 1), cA + hstep, voffA);
        if (wr == 1) PG8_BAR;
        PG8_WAIT_V(4); PG8_BAR;
        PG8_STAGE(PG8_SB(1, 0), cB + kstep, voffB); PG8_STAGE(PG8_SA(1, 0), cA + kstep, voffA); PG8_STAGE(PG8_SB(1, 1), cB + hstep + kstep, voffB);
        PG8_WAIT_V(6); PG8_BAR;
    }
    for (;;) {
        const bool has_next = S.next(ui + 1, nxt);
        if constexpr (Epi::KHOOK) E.unit_begin(cur, lds + STAGE_BYTES + (ui & 1) * 8192, tid);
        const char* nA = has_next ? (const char*)g.A + (size_t)nxt.pm * tstep + (SPLITK ? (size_t)nxt.pn * K * 2 : (size_t)0) : cA; const char* nB = has_next ? (const char*)g.Bt + (SPLITK ? (size_t)nxt.pn * K * 2 : (size_t)nxt.pn * tstep) : cB;
        for (int t = 0; t < nt; t += 2) {
            const bool last = (t == nt - 2);
            const char* a1 = cA + (size_t)(t + 1) * kstep;
            const char* a2 = last ? nA : cA + (size_t)(t + 2) * kstep; const char* b2 = last ? nB : cB + (size_t)(t + 2) * kstep;
            const char* a3 = a2 + kstep; const char* b3 = b2 + kstep;
            if (last && has_next) S.a_ready(nxt);
            if constexpr (SP2) {
            PG8_LDB(B0, 0, 0); PG8_LDB(B1, 0, 1); PG8_SCHED; PG8_LDA(At, 0, 0); PG8_STAGE(PG8_SA(1, 1), a1 + hstep, voffA);
            PG8_WAIT_V(8); PG8_WAIT_L(0); PG8_BAR; PG8_MMA(0, 0, At, B0); PG8_MMA(0, 1, At, B1); PG8_BAR; PG8_SCHED;
            PG8_LDA(At, 0, 1); PG8_STAGE(PG8_SB(0, 0), b2, voffB); PG8_STAGE(PG8_SB(0, 1), b2 + hstep, voffB); PG8_STAGE(PG8_SA(0, 0), a2, voffA);
            PG8_WAIT_V(8); PG8_WAIT_L(0); PG8_BAR; PG8_MMA(1, 0, At, B0); PG8_MMA(1, 1, At, B1); PG8_BAR; PG8_SCHED;
            PG8_LDB(B0, 1, 0); PG8_LDB(B1, 1, 1); PG8_SCHED; PG8_LDA(At, 1, 0); PG8_STAGE(PG8_SA(0, 1), a2 + hstep, voffA);
            PG8_WAIT_V(8); PG8_WAIT_L(0); PG8_BAR; PG8_MMA(0, 0, At, B0); PG8_MMA(0, 1, At, B1); PG8_BAR; PG8_SCHED;
            PG8_LDA(At, 1, 1); PG8_STAGE(PG8_SB(1, 0), b3, voffB); PG8_STAGE(PG8_SB(1, 1), b3 + hstep, voffB); PG8_STAGE(PG8_SA(1, 0), a3, voffA);
            PG8_WAIT_V(8); PG8_WAIT_L(0); PG8_BAR; PG8_MMA(1, 0, At, B0); PG8_MMA(1, 1, At, B1); PG8_BAR; PG8_SCHED;
            if constexpr (Epi::KHOOK) { if ((t & 15) == 14 && !last) { E.khook(acc, lds + STAGE_BYTES + (ui & 1) * 8192, t >> 4, wr, fr); } }
            } else {
            PG8_LDB(B0, 0, 0); PG8_SCHED; PG8_LDA(At, 0, 0); PG8_STAGE(PG8_SA(1, 1), a1 + hstep, voffA);
            PG8_WAIT_L(8); PG8_BAR; PG8_WAIT_L(0); PG8_MMA(0, 0, At, B0); PG8_BAR; PG8_SCHED;
            PG8_LDB(B1, 0, 1); PG8_STAGE(PG8_SB(0, 0), b2, voffB);
            PG8_BAR; PG8_WAIT_L(0); PG8_MMA(0, 1, At, B1); PG8_BAR;
            PG8_LDA(At, 0, 1); PG8_STAGE(PG8_SA(0, 0), a2, voffA);
            PG8_BAR; PG8_WAIT_L(0); PG8_MMA(1, 0, At, B0); PG8_BAR; PG8_SCHED;
            PG8_STAGE(PG8_SB(0, 1), b2 + hstep, voffB);
            PG8_WAIT_V(6); PG8_BAR; PG8_MMA(1, 1, At, B1); PG8_BAR;
            PG8_LDB(B0, 1, 0); PG8_SCHED; PG8_LDA(At, 1, 0); PG8_STAGE(PG8_SA(0, 1), a2 + hstep, voffA);
            PG8_WAIT_L(8); PG8_BAR; PG8_WAIT_L(0); PG8_MMA(0, 0, At, B0); PG8_BAR; PG8_SCHED;
            PG8_LDB(B1, 1, 1); PG8_STAGE(PG8_SB(1, 0), b3, voffB);
            PG8_BAR; PG8_WAIT_L(0); PG8_MMA(0, 1, At, B1); PG8_BAR;
            PG8_LDA(At, 1, 1); PG8_STAGE(PG8_SA(1, 0), a3, voffA);
            PG8_BAR; PG8_WAIT_L(0); PG8_MMA(1, 0, At, B0); PG8_BAR; PG8_SCHED;
            PG8_STAGE(PG8_SB(1, 1), b3 + hstep, voffB);
            PG8_WAIT_V(6); PG8_BAR; PG8_MMA(1, 1, At, B1); PG8_BAR;
            }
        }
        if constexpr (ALIGN_EPI) { if (wr == 0) PG8_BAR; }
        if constexpr (!Epi::AFTER_DRAIN) { if constexpr (Epi::KHOOK) E.epi(acc, cur, wr, wc, fr, fq, lds + STAGE_BYTES + (ui & 1) * 8192); else E(acc, cur, wr, wc, fr, fq); S.done(cur); }
        if (!has_next) break;
#pragma unroll
        for (int a = 0; a < 2; ++a)
#pragma unroll
            for (int b = 0; b < 2; ++b)
#pragma unroll
                for (int m = 0; m < 4; ++m)
#pragma unroll
                    for (int n = 0; n < 2; ++n) acc[a][b][m][n] = (f32x4){0.f, 0.f, 0.f, 0.f};
        cur = nxt; cA = nA; cB = nB; ++ui;
        if constexpr (ALIGN_EPI) { if (wr == 1) PG8_BAR; }
    }
    PG8_WAIT_V(0);
    if constexpr (!ALIGN_EPI) { if (wr == 0) PG8_BAR; }
    PG8_BAR;
    if constexpr (Epi::AFTER_DRAIN) { E.fused(acc, cur, wr, wc, fr, fq, lds, wid, lane); S.done(cur); }
#undef PG8_SA
#undef PG8_SB
#undef PG8_STAGE
#undef PG8_LDA
#undef PG8_LDB
#undef PG8_MMA
#undef PG8_WAIT_V
#undef PG8_WAIT_L
#undef PG8_BAR
#undef PG8_SCHED
}
}
#ifndef PG8_SP2
#define PG8_SP2 true
#endif
#ifndef PG8_ALIGN
#define PG8_ALIGN true
#endif
constexpr int NWAVES = 8;
#ifndef MK_N_LAUNCHES
#define MK_N_LAUNCHES 1
#endif
constexpr int NPH = 11;
constexpr int N_LAUNCHES = MK_N_LAUNCHES;

constexpr int M = 8192, D = 4096;
constexpr int S5G = 256, S5P = 16, S5N = 64;
constexpr int DI = 8192, NH = 128, HD = 64, NG = 8, NS = 128, CONVD = 10240;
constexpr int IN_COLS = 34944, NPROJ = 35072, NMAIN = 34816;
constexpr float EPS = 1e-6f;

constexpr size_t MiB = 1u << 20;
constexpr size_t WS_CTL = 0, CTL_ZERO_BYTES = 1 * MiB;
constexpr size_t WS_MODP = 1 * MiB;
constexpr size_t WS_GATE = 1 * MiB + 512 * 1024;
constexpr size_t WS_SS = 2 * MiB;
constexpr size_t WS_S5C = 2 * MiB;
constexpr size_t WS_DT = 4 * MiB;
constexpr size_t WS_WGLU = 8 * MiB, WS_WBRS = 72 * MiB, WS_WBRM = 104 * MiB, WS_WOUT = 168 * MiB;
constexpr size_t WS_U = 200 * MiB;
constexpr size_t WS_SZ = 264 * MiB;
constexpr size_t WS_MZ = 328 * MiB;
constexpr size_t WS_XBC = 456 * MiB;
constexpr size_t WS_G1 = 616 * MiB, WS_G2 = 680 * MiB;
constexpr size_t WS_WIN = 744 * MiB;
constexpr size_t WS_YSSD = 744 * MiB, WS_YM2 = 872 * MiB;
constexpr size_t WS_H = 1018 * MiB;
constexpr size_t WS_YS5 = 1018 * MiB;
constexpr size_t WS_XC = 1082 * MiB;
constexpr size_t WS_DTS = 1242 * MiB;
constexpr size_t WS_END = 1246 * MiB;
constexpr size_t WS_YS5G = WS_U, WS_MERGED = WS_SZ, WS_T1 = WS_MZ;
constexpr size_t WS_X2 = WS_G1;
static_assert(WS_WIN + (size_t)NPROJ * D * 2 <= WS_H && WS_H + (size_t)M * D * 2 <= WS_XC && WS_XC + (size_t)M * CONVD * 2 <= WS_DTS, "d_ws map");
constexpr int CW_BAR = 4096;

constexpr int RING_OFF = 0, RING_BYTES = 131072;
constexpr int LDSCTL_OFF = 151552, MISC_OFF = LDSCTL_OFF + 320;
constexpr int LDS_BYTES = 155648;
static_assert(MISC_OFF + 128 <= LDS_BYTES, "LDS map");

#define GAS __attribute__((address_space(1)))
#define LAS __attribute__((address_space(3)))
typedef unsigned short bf16;
typedef unsigned v4u __attribute__((ext_vector_type(4)));
typedef unsigned v2u __attribute__((ext_vector_type(2)));
typedef float f32x4 __attribute__((ext_vector_type(4)));
typedef short bf16x8 __attribute__((ext_vector_type(8)));
typedef GAS unsigned gu32;
#define RLX_AGENT __ATOMIC_RELAXED, __HIP_MEMORY_SCOPE_AGENT
#define LDS_WAIT() asm volatile("s_waitcnt lgkmcnt(0)" ::: "memory")
#define VM_WAIT() asm volatile("s_waitcnt vmcnt(0)" ::: "memory")
typedef float f32x2c __attribute__((ext_vector_type(2)));
typedef __bf16 bf16x2c __attribute__((ext_vector_type(2)));
__device__ __forceinline__ unsigned pk2(float lo, float hi) { return __builtin_bit_cast(unsigned, __builtin_convertvector(((f32x2c){lo, hi}), bf16x2c)); }
__device__ __forceinline__ unsigned f2bf(float f) { return pk2(f, 0.f) & 0xffffu; }
__device__ __forceinline__ float bf2f(bf16 h) { return __builtin_bit_cast(float, (unsigned)h << 16); }
using pg8::bf_lo; using pg8::bf_hi;
#define XB_TMO      128
#define XB_XCNT(j)  (256  + 64 * (j))
#define XB_XSUB(j)  (1280 + 64 * (j))
#define XB_XGEN(j)  (2304 + 64 * (j))
#define XB_TOP      3328
#define XB_TOPGEN   3392
#define XCD_BAR_WORDS 3456
#define XB_SPIN_CAP (1u << 18)

__device__ __forceinline__ unsigned xb_ld(unsigned* p)              { return __hip_atomic_load(p, __ATOMIC_RELAXED, __HIP_MEMORY_SCOPE_AGENT); }
__device__ __forceinline__ unsigned xb_add(unsigned* p, unsigned v) { return __hip_atomic_fetch_add(p, v, __ATOMIC_RELAXED, __HIP_MEMORY_SCOPE_AGENT); }
__device__ __forceinline__ unsigned xb_xcc_id() { return (unsigned)__builtin_amdgcn_s_getreg((3 << 11) | 20) & 0xFu; }
#define XB_SPIN(cond, bar) do { unsigned _sp = 0; while (cond) { __builtin_amdgcn_s_sleep(1); \
    if ((++_sp & 255u) == 0u) { if (xb_ld(&(bar)[XB_TMO])) break; if (_sp > XB_SPIN_CAP) { atomicAdd(&(bar)[XB_TMO], 1u); break; } } } } while (0)

struct XcdBarrier {
    unsigned* bar; unsigned x;
    volatile LAS unsigned* st;
};

__device__ __forceinline__ XcdBarrier xcd_barrier_post(unsigned* bar, volatile LAS unsigned* st) {
    XcdBarrier b; b.bar = bar; b.x = xb_xcc_id(); b.st = st;
    if (threadIdx.x == 0) (void)xb_add(&bar[XB_XCNT(b.x)], 1u);
    return b;
}
__device__ __forceinline__ void xcd_barrier_complete(unsigned* bar, unsigned x, unsigned& nloc, unsigned& nx) {
    const unsigned G = gridDim.x * gridDim.y * gridDim.z;
    unsigned sum, cnt, mine, sp = 0u;
    for (;;) {
        sum = 0u; cnt = 0u; mine = 0u;
#pragma unroll
        for (unsigned j = 0; j < 16; ++j) { const unsigned c = xb_ld(&bar[XB_XCNT(j)]); sum += c; cnt += (c > 0u) ? 1u : 0u; mine = (j == x) ? c : mine; }
        if (sum == G) break;
        __builtin_amdgcn_s_sleep(1);
        if ((++sp & 255u) == 0u) { if (xb_ld(&bar[XB_TMO])) break; if (sp > XB_SPIN_CAP) { atomicAdd(&bar[XB_TMO], 1u); break; } }
    }
    nloc = mine > 0u ? mine : 1u; nx = cnt > 0u ? cnt : 1u;
}

__device__ __forceinline__ void xcd_barrier(const XcdBarrier& b) {
    asm volatile("s_waitcnt vmcnt(0)" ::: "memory");
    __syncthreads();
    if (threadIdx.x == 0) {
        unsigned* bar = b.bar;
        __builtin_amdgcn_s_waitcnt(0);
        unsigned nloc = b.st[0], nx = b.st[1];
        if (nloc == 0u) { xcd_barrier_complete(bar, b.x, nloc, nx); b.st[0] = nloc; b.st[1] = nx; }
        const unsigned old = xb_add(&bar[XB_XSUB(b.x)], 1u);
        const unsigned gen = old / nloc;
        if (old + 1u == (gen + 1u) * nloc) {
            __builtin_amdgcn_fence(__ATOMIC_RELEASE, "agent");
            asm volatile("s_waitcnt vmcnt(0)" ::: "memory");
            const unsigned og = xb_add(&bar[XB_TOP], 1u);
            const unsigned tg = og / nx;
            if (og + 1u == (tg + 1u) * nx) xb_add(&bar[XB_TOPGEN], 1u);
            else XB_SPIN(xb_ld(&bar[XB_TOPGEN]) == tg, bar);
            __builtin_amdgcn_fence(__ATOMIC_ACQUIRE, "agent");
            xb_add(&bar[XB_XGEN(b.x)], 1u);
            asm volatile("s_waitcnt vmcnt(0)" ::: "memory");
        } else {
            XB_SPIN(xb_ld(&bar[XB_XGEN(b.x)]) == gen, bar);
            __builtin_amdgcn_fence(__ATOMIC_ACQUIRE, "agent");
            asm volatile("s_waitcnt vmcnt(0)" ::: "memory");
        }
    }
    __syncthreads();
}
__device__ __forceinline__ float wave_sum(float v) {
#pragma unroll
    for (int o = 1; o < 64; o <<= 1) v += __shfl_xor(v, o);
    return v;
}
constexpr int TR_PITCH = 34, TR_BYTES = 64 * TR_PITCH * 2;
__device__ __forceinline__ void p0_transpose_item(const float* W, int K, int N, bf16* WT, int src_n0, int dst_n0, int k0, LAS bf16* scr, int lane, const float* kscale = nullptr) {
    if (src_n0 >= 0) {
        f32x4 v[8];
#pragma unroll
        for (int i = 0; i < 8; ++i) v[i] = __builtin_nontemporal_load((const GAS f32x4*)(W + (size_t)(k0 + 8 * i + (lane >> 3)) * N + src_n0 + 4 * (lane & 7)));
        if (kscale) {
#pragma unroll
            for (int i = 0; i < 8; ++i) v[i] = v[i] * kscale[k0 + 8 * i + (lane >> 3)]; }
#pragma unroll
        for (int i = 0; i < 8; ++i) { LAS unsigned* d = (LAS unsigned*)(scr + (8 * i + (lane >> 3)) * TR_PITCH + 4 * (lane & 7)); d[0] = pk2(v[i].x, v[i].y); d[1] = pk2(v[i].z, v[i].w); }
    } else {
#pragma unroll
        for (int i = 0; i < 8; ++i) { LAS unsigned* d = (LAS unsigned*)(scr + (8 * i + (lane >> 3)) * TR_PITCH + 4 * (lane & 7)); d[0] = 0u; d[1] = 0u; }
    }
    LDS_WAIT(); asm volatile("" ::: "memory");
    const int c = lane & 7;
#pragma unroll
    for (int j = 0; j < 4; ++j) { const int n = (lane >> 3) + 8 * j; const LAS bf16* s = scr + (8 * c) * TR_PITCH + n;
        v4u o; o.x = (unsigned)s[0] | ((unsigned)s[TR_PITCH] << 16); o.y = (unsigned)s[2 * TR_PITCH] | ((unsigned)s[3 * TR_PITCH] << 16);
        o.z = (unsigned)s[4 * TR_PITCH] | ((unsigned)s[5 * TR_PITCH] << 16); o.w = (unsigned)s[6 * TR_PITCH] | ((unsigned)s[7 * TR_PITCH] << 16);
        *(GAS v4u*)(WT + (size_t)(dst_n0 + n) * K + k0 + 8 * c) = o; }
    LDS_WAIT(); asm volatile("" ::: "memory");
}
__device__ __forceinline__ int win_src_col(int d) { return d < 26624 ? d : (d < 34816 ? d + 128 : (d < 34944 ? d - 34816 + 26624 : -1)); }
__device__ __forceinline__ int wglu_src_col(int d) { const int pn = d >> 8, r = d & 255; return r < 128 ? 128 * pn + r : 4096 + 128 * pn + (r - 128); }

struct Args {
    const float *x, *c, *w_ada, *b_ada, *norm_g, *w_in, *lam_re, *lam_im, *log_step, *b_re, *b_im, *c_re, *c_im, *s5_d, *w_glu, *b_glu,
                *conv_w, *conv_b, *dt_bias, *a_log, *m2_d, *m2_norm_g, *w_br_s5, *w_br_m2, *w_out, *final_g;
    float* out; unsigned char* ws; int ph_lo, ph_hi, sub, pad;
};

__device__ __forceinline__ void p0_gemv(const float* c, const float* W, float* MODP, LAS float* red, int wg, int G, int tid) {
    const int cg = tid & 31, rg = tid >> 5;
    for (int it = wg; it < 768; it += G) {
        const int cb = it % 96, ks = it / 96;
        const float* wp = W + (size_t)(ks * 512 + rg) * 12288 + cb * 128 + cg * 4;
        const float* cp = c + ks * 512 + rg;
        f32x4 acc = (f32x4){0.f, 0.f, 0.f, 0.f};
#pragma unroll 8
        for (int i = 0; i < 32; ++i) { const f32x4 w = __builtin_nontemporal_load((const f32x4*)(wp + (size_t)i * 16 * 12288)); const float cv = cp[i * 16]; acc = acc + w * cv; }
        *(LAS f32x4*)(red + rg * 128 + cg * 4) = acc;
        __syncthreads();
        if (tid < 128) { float s = 0.f;
#pragma unroll
            for (int r = 0; r < 16; ++r) s += red[r * 128 + tid];
            MODP[ks * 12288 + cb * 128 + tid] = s; }
        __syncthreads();
    }
}
__device__ __forceinline__ void p0_weights_in(const Args& a, LAS bf16* scr, int gw, int NGW, int lane) {
    bf16* WIN = (bf16*)(a.ws + WS_WIN);
    constexpr int I_IN = (D / 64) * (NPROJ / 32);
    for (int r = gw; r < I_IN; r += NGW) { const int nblk = NPROJ / 32, kb = r / nblk, nb = r % nblk; p0_transpose_item(a.w_in, D, IN_COLS, WIN, win_src_col(32 * nb), 32 * nb, 64 * kb, scr, lane); }
}
constexpr int P3_NCONV = 16 * 512, P3_NWITEMS = (D / 64) * (8192 / 32) + 2 * (D / 64) * (D / 32) + (DI / 64) * (D / 32);
__device__ __forceinline__ void p3_weight_item(const Args& a, LAS bf16* scr, int it, int lane) {
    bf16* WGLU = (bf16*)(a.ws + WS_WGLU); bf16* WBRS = (bf16*)(a.ws + WS_WBRS); bf16* WBRM = (bf16*)(a.ws + WS_WBRM); bf16* WOUT = (bf16*)(a.ws + WS_WOUT);
    constexpr int I_GLU = (D / 64) * (8192 / 32), I_BRS = (D / 64) * (D / 32), I_BRM = (DI / 64) * (D / 32), I_OUT = (D / 64) * (D / 32);
    static_assert(I_GLU + I_BRS + I_BRM + I_OUT == P3_NWITEMS, "item count");
    int r = it;
    if (r < I_GLU) { const int nblk = 8192 / 32, kb = r / nblk, nb = r % nblk; p0_transpose_item(a.w_glu, D, 8192, WGLU, wglu_src_col(32 * nb), 32 * nb, 64 * kb, scr, lane); return; } r -= I_GLU;
    if (r < I_BRS) { const int nblk = D / 32, kb = r / nblk, nb = r % nblk; p0_transpose_item(a.w_br_s5, D, D, WBRS, 32 * nb, 32 * nb, 64 * kb, scr, lane); return; } r -= I_BRS;
    if (r < I_BRM) { const int nblk = D / 32, kb = r / nblk, nb = r % nblk; p0_transpose_item(a.w_br_m2, DI, D, WBRM, 32 * nb, 32 * nb, 64 * kb, scr, lane, a.m2_norm_g); return; } r -= I_BRM;
    { const int nblk = D / 32, kb = r / nblk, nb = r % nblk; p0_transpose_item(a.w_out, D, D, WOUT, 32 * nb, 32 * nb, 64 * kb, scr, lane); }
}
__device__ __forceinline__ void p1_h(const Args& a, LAS float* ldsA, LAS float* ldsB, int gw, int NGW, int tid, int lane) {
    const float* MODP = (const float*)(a.ws + WS_MODP); float* GATE = (float*)(a.ws + WS_GATE); bf16* H = (bf16*)(a.ws + WS_H);
    for (int j = tid; j < 12288; j += NWAVES * 64) { float s = a.b_ada[j];
#pragma unroll
        for (int ks = 0; ks < 8; ++ks) s += MODP[ks * 12288 + j];
        if (j < 4096) ldsB[j] = s; else if (j < 8192) ldsA[j - 4096] = a.norm_g[j - 4096] * (1.0f + s); else if (blockIdx.x == 0) GATE[j - 8192] = s; }
    __syncthreads();
    for (int row = gw; row < M; row += NGW) {
        const GAS f32x4* xr = (const GAS f32x4*)(a.x + (size_t)row * D);
        f32x4 v[16]; float ss = 0.f;
#pragma unroll
        for (int j = 0; j < 8; ++j) { v[2 * j] = __builtin_nontemporal_load(xr + 128 * j + 2 * lane); v[2 * j + 1] = __builtin_nontemporal_load(xr + 128 * j + 2 * lane + 1); }
#pragma unroll
        for (int j = 0; j < 16; ++j) ss += (v[j].x * v[j].x + v[j].y * v[j].y) + (v[j].z * v[j].z + v[j].w * v[j].w);
        const float rstd = 1.0f / sqrtf(wave_sum(ss) * (1.0f / D) + EPS);
#pragma unroll
        for (int j = 0; j < 8; ++j) { const int col = 512 * j + 8 * lane;
            const f32x4 a0 = *(const LAS f32x4*)(ldsA + col), a1 = *(const LAS f32x4*)(ldsA + col + 4), b0 = *(const LAS f32x4*)(ldsB + col), b1 = *(const LAS f32x4*)(ldsB + col + 4);
            const f32x4 h0 = v[2 * j] * rstd * a0 + b0, h1 = v[2 * j + 1] * rstd * a1 + b1;
            v4u o; o.x = pk2(h0.x, h0.y); o.y = pk2(h0.z, h0.w); o.z = pk2(h1.x, h1.y); o.w = pk2(h1.z, h1.w);
            *(GAS v4u*)(H + (size_t)row * D + col) = o; }
    }
}
__device__ __forceinline__ float gelu_tanh(float x) { const float z = 0.7978845608028654f * (x + 0.044715f * x * x * x); return x * __builtin_amdgcn_rcpf(1.0f + __expf(-2.0f * z)); }
__device__ __forceinline__ float softplus_f(float x) { return fmaxf(x, 0.f) + log1pf(expf(-fabsf(x))); }
__device__ __forceinline__ void conv_task(const Args& a, int task, int lane) {
    const bf16* XBC = (const bf16*)(a.ws + WS_XBC); bf16* XC = (bf16*)(a.ws + WS_XC);
    {
        const int cb = task & 15, t0 = (task >> 4) * 16;
        const int c8 = (cb * 64 + lane) * 8;
        f32x4 w0[4], w1[4];
#pragma unroll
        for (int k = 0; k < 4; ++k) { w0[k] = *(const f32x4*)(a.conv_w + k * CONVD + c8); w1[k] = *(const f32x4*)(a.conv_w + k * CONVD + c8 + 4); }
        const f32x4 b0 = *(const f32x4*)(a.conv_b + c8), b1 = *(const f32x4*)(a.conv_b + c8 + 4);
        v4u raw[19];
#pragma unroll
        for (int i = 0; i < 19; ++i) { const int tt = t0 - 3 + i; raw[i] = (v4u){0u, 0u, 0u, 0u}; if (tt >= 0) raw[i] = __builtin_nontemporal_load((const GAS v4u*)(XBC + (size_t)tt * CONVD + c8)); }
        f32x4 r0[4], r1[4];
#pragma unroll
        for (int i = 0; i < 3; ++i) pg8::unpack8(raw[i], r0[i], r1[i]);
#pragma unroll
        for (int i = 3; i < 19; ++i) { pg8::unpack8(raw[i], r0[i & 3], r1[i & 3]);
            f32x4 acc0 = b0, acc1 = b1;
#pragma unroll
            for (int k = 0; k < 4; ++k) { acc0 = acc0 + r0[(i - 3 + k) & 3] * w0[k]; acc1 = acc1 + r1[(i - 3 + k) & 3] * w1[k]; }
#pragma unroll
            for (int e = 0; e < 4; ++e) { acc0[e] = pg8::silu_f(acc0[e]); acc1[e] = pg8::silu_f(acc1[e]); }
            v4u o; o.x = pk2(acc0.x, acc0.y); o.y = pk2(acc0.z, acc0.w); o.z = pk2(acc1.x, acc1.y); o.w = pk2(acc1.z, acc1.w);
            *(GAS v4u*)(XC + (size_t)(t0 + i - 3) * CONVD + c8) = o; }
    }
}
__device__ __forceinline__ void final_norm(const Args& a, int gw, int NGW, int lane) {
    const float* SS = (const float*)(a.ws + WS_SS); const bf16* X2 = (const bf16*)(a.ws + WS_X2);
    for (int row = gw; row < M; row += NGW) {
        const GAS v4u* xr = (const GAS v4u*)(X2 + (size_t)row * D); GAS f32x4* orow = (GAS f32x4*)(a.out + (size_t)row * D);
        v4u r[8];
#pragma unroll
        for (int j = 0; j < 8; ++j) r[j] = xr[64 * j + lane];
        const float rstd = 1.0f / sqrtf(wave_sum(SS[(size_t)row * 64 + lane]) * (1.0f / D) + EPS);
#pragma unroll
        for (int j = 0; j < 8; ++j) { const int col = 512 * j + 8 * lane; f32x4 v0, v1; pg8::unpack8(r[j], v0, v1);
            orow[128 * j + 2 * lane] = v0 * rstd * *(const f32x4*)(a.final_g + col); orow[128 * j + 2 * lane + 1] = v1 * rstd * *(const f32x4*)(a.final_g + col + 4); }
    }
}
constexpr int P3_CNT_OFF = 139264;
__device__ __forceinline__ void p3_stream_items(const Args& a, LAS unsigned char* L, LAS bf16* scr, int vcu, int G, int lane) {
    LAS unsigned* cnt = (LAS unsigned*)(L + P3_CNT_OFF);
    for (;;) {
        unsigned idx = 0u; if (lane == 0) idx = __hip_atomic_fetch_add(cnt, 1u, __ATOMIC_RELAXED, __HIP_MEMORY_SCOPE_WORKGROUP);
        idx = (unsigned)__builtin_amdgcn_readfirstlane((int)idx);
        const long id = (long)idx * G + vcu;
        if (id < P3_NCONV) conv_task(a, (int)id, lane);
        else if (id < P3_NCONV + P3_NWITEMS) p3_weight_item(a, scr, (int)(id - P3_NCONV), lane);
        else break;
    }
}
__device__ __forceinline__ void s5_consts(const Args& a, size_t gt, size_t NT) {
    float* S5C = (float*)(a.ws + WS_S5C);
    for (size_t idx = gt; idx < (size_t)S5G * S5N; idx += NT) {
        const int g = (int)(idx >> 6);
        const double step = exp((double)a.log_step[g]);
        const double lre = (double)a.lam_re[idx], lim = (double)a.lam_im[idx];
        const double mag = exp(lre * step), ang = lim * step;
        const double lbr_d = mag * cos(ang), lbi_d = mag * sin(ang);
        const double den = lre * lre + lim * lim, nr = lbr_d - 1.0, ni = lbi_d;
        const double cr = (nr * lre + ni * lim) / den, ci = (ni * lre - nr * lim) / den;
        const float lbr = (float)lbr_d, lbi = (float)lbi_d;
        double pr = (double)lbr, pi = (double)lbi;
#pragma unroll 1
        for (int i = 0; i < 11; ++i) { const double r2 = pr * pr - pi * pi, i2 = 2.0 * pr * pi; pr = r2; pi = i2; }
        *(f32x4*)(S5C + idx * 8) = (f32x4){lbr, lbi, (float)cr, (float)ci}; *(f32x4*)(S5C + idx * 8 + 4) = (f32x4){(float)pr, (float)pi, 0.f, 0.f};
    }
}
constexpr int S5W = 4, S5_SEG = M / S5W, S5_NCH = S5_SEG / 128, S5_NNB = S5_SEG / 256, S5_TQ = 8 / S5W;
constexpr int S5_APP = 264;
constexpr int S5_WLDS = 16896, S5_BU = 0, S5_SB = 8448, S5_US = 12800, S5_E = 8 * S5_WLDS;
typedef float f32x2v __attribute__((ext_vector_type(2)));
#define MFMA16(a, b, c) __builtin_amdgcn_mfma_f32_16x16x32_bf16((a), (b), (c), 0, 0, 0)
__device__ __forceinline__ void s5_bu_to_lds(const bf16x8 (&Af)[8], const bf16x8 Bf, LAS float* Bu, int lane) {
#pragma unroll
    for (int mb = 0; mb < 8; ++mb) { const f32x4 d = MFMA16(Af[mb], Bf, ((f32x4){0.f, 0.f, 0.f, 0.f})); *(LAS f32x4*)(Bu + (lane & 15) * 132 + 16 * mb + 4 * (lane >> 4)) = d; }
    LDS_WAIT(); asm volatile("" ::: "memory");
}
template <bool FULL> __device__ __forceinline__ void s5_sub(const bf16x8 (&Af)[8], const bf16x8 (&Cf)[4], const f32x4 d4, const bf16x8 Bf, const v2u u4raw, float& sr, float& si, float lbr, float lbi,
                                                            LAS float* Bu, LAS bf16* Sb, bf16* yrow, int lane) {
    s5_bu_to_lds(Af, Bf, Bu, lane);
    f32x2v b[16];
#pragma unroll
    for (int t = 0; t < 16; ++t) b[t] = *(const LAS f32x2v*)(Bu + t * 132 + 2 * lane);
#pragma unroll
    for (int t = 0; t < 16; ++t) { const float nsr = fmaf(lbr, sr, fmaf(-lbi, si, b[t].x)), nsi = fmaf(lbr, si, fmaf(lbi, sr, b[t].y)); sr = nsr; si = nsi;
        if (FULL) *(LAS unsigned*)(Sb + t * 136 + 2 * lane) = pk2(sr, si); }
    if (FULL) {
        LDS_WAIT(); asm volatile("" ::: "memory");
        f32x4 acc = (f32x4){0.f, 0.f, 0.f, 0.f};
#pragma unroll
        for (int kb = 0; kb < 4; ++kb) { const bf16x8 Sf = *(const LAS bf16x8*)(Sb + (lane & 15) * 136 + 32 * kb + 8 * (lane >> 4)); acc = MFMA16(Cf[kb], Sf, acc); }
        const float u0 = bf_lo(u4raw.x), u1 = bf_hi(u4raw.x), u2 = bf_lo(u4raw.y), u3 = bf_hi(u4raw.y);
        const float y0 = gelu_tanh(acc[0] + d4[0] * u0), y1 = gelu_tanh(acc[1] + d4[1] * u1), y2 = gelu_tanh(acc[2] + d4[2] * u2), y3 = gelu_tanh(acc[3] + d4[3] * u3);
        v2u o; o.x = pk2(y0, y1); o.y = pk2(y2, y3);
        *(GAS v2u*)(yrow + (size_t)(lane & 15) * D + 4 * (lane >> 4)) = o;
        asm volatile("" ::: "memory");
    }
}
__device__ __forceinline__ void s5_fast_group(const Args& a, int g, LAS unsigned char* L, int vcu, int G, int wave, int lane) {
    const bf16* U = (const bf16*)(a.ws + WS_U); bf16* YS5 = (bf16*)(a.ws + WS_YS5);
    LAS float* Bu = (LAS float*)(L + wave * S5_WLDS + S5_BU); LAS bf16* Sb = (LAS bf16*)(L + wave * S5_WLDS + S5_SB); LAS f32x2v* E = (LAS f32x2v*)(L + S5_E);
    float lbr, lbi, pwr, pwi;
    const float* S5C = (const float*)(a.ws + WS_S5C);
    { const f32x4 c0 = *(const f32x4*)(S5C + (size_t)(g * 64 + lane) * 8); const f32x2v c1 = *(const f32x2v*)(S5C + (size_t)(g * 64 + lane) * 8 + 4);
      lbr = c0[0]; lbi = c0[1]; pwr = c1.x; pwi = c1.y; }
    const bf16* ug = U + (size_t)g * M * 16; const int tw = wave * S5_SEG;
    LAS unsigned char* Us = L + wave * S5_WLDS + S5_US;
    const GAS v4u* useg = (const GAS v4u*)(ug + (size_t)tw * 16);
    const int bf_off = 32 * (lane & 15) + 16 * (lane >> 4), u4_off = 32 * (lane & 15) + 8 * (lane >> 4);
    {   LAS bf16* AP = (LAS bf16*)L;
#pragma unroll 1
        for (int tq = wave * S5_TQ; tq < (wave + 1) * S5_TQ; ++tq) { const int n = lane; const int e0 = 14 - 2 * tq;
          const f32x4 c0 = *(const f32x4*)(S5C + (size_t)(g * 64 + n) * 8);
          float pr = 1.f, pi = 0.f;
          for (int k = 0; k < e0; ++k) { const float r2 = pr * c0[0] - pi * c0[1], i2 = pr * c0[1] + pi * c0[0]; pr = r2; pi = i2; }
          const float qr = pr * c0[0] - pi * c0[1], qi = pr * c0[1] + pi * c0[0];
          const float* pbr = a.b_re + (size_t)(g * 64 + n) * 16; const float* pbi = a.b_im + (size_t)(g * 64 + n) * 16;
          LAS bf16* rre = AP + (32 * (n >> 4) + (n & 15)) * S5_APP + 32 * tq; LAS bf16* rim = rre + 16 * S5_APP;
#pragma unroll
          for (int q4 = 0; q4 < 4; ++q4) { const f32x4 br = *(const f32x4*)(pbr + 4 * q4), bi = *(const f32x4*)(pbi + 4 * q4);
              float xr[4], xi[4], yr[4], yi[4];
#pragma unroll
              for (int e = 0; e < 4; ++e) { const float bbr = c0[2] * br[e] - c0[3] * bi[e], bbi = c0[2] * bi[e] + c0[3] * br[e];
                  xr[e] = qr * bbr - qi * bbi; xi[e] = qr * bbi + qi * bbr; yr[e] = pr * bbr - pi * bbi; yi[e] = pr * bbi + pi * bbr; }
              *(LAS v2u*)(rre + 4 * q4) = (v2u){pk2(xr[0], xr[1]), pk2(xr[2], xr[3])}; *(LAS v2u*)(rim + 4 * q4) = (v2u){pk2(xi[0], xi[1]), pk2(xi[2], xi[3])};
              *(LAS v2u*)(rre + 16 + 4 * q4) = (v2u){pk2(yr[0], yr[1]), pk2(yr[2], yr[3])}; *(LAS v2u*)(rim + 16 + 4 * q4) = (v2u){pk2(yi[0], yi[1]), pk2(yi[2], yi[3])}; } }
        __syncthreads();
        float mur[4], mui[4], m13r[4], m13i[4], wqr[4], wqi[4];
#pragma unroll
        for (int mp = 0; mp < 4; ++mp) { const f32x2v lb = *(const f32x2v*)(S5C + (size_t)(g * 64 + 16 * mp + (lane & 15)) * 8);
            float r = lb.x, i = lb.y;
#pragma unroll
            for (int k = 0; k < 4; ++k) { const float r2 = r * r - i * i, i2 = 2.f * r * i; r = r2; i = i2; }
            const float m2r = r * r - i * i, m2i = 2.f * r * i, m4r = m2r * m2r - m2i * m2i, m4i = 2.f * m2r * m2i, m8r = m4r * m4r - m4i * m4i, m8i = 2.f * m4r * m4i;
            const float m12r = m8r * m4r - m8i * m4i, m12i = m8r * m4i + m8i * m4r;
            mur[mp] = r; mui[mp] = i; m13r[mp] = m12r; m13i[mp] = m12i;
            const int q = lane >> 4; wqr[mp] = q == 0 ? m12r : (q == 1 ? m8r : (q == 2 ? m4r : 1.f)); wqi[mp] = q == 0 ? m12i : (q == 1 ? m8i : (q == 2 ? m4i : 0.f)); }
        float zr[4] = {0.f, 0.f, 0.f, 0.f}, zi[4] = {0.f, 0.f, 0.f, 0.f};
#pragma unroll 1
        for (int nb = 0; nb < S5_NNB; ++nb) {
            bf16x8 Uf[8];
            const bf16* up = ug + (size_t)(tw + 16 * (16 * nb + (lane & 15))) * 16 + 8 * (lane >> 4);
#pragma unroll
            for (int kb = 0; kb < 8; ++kb) Uf[kb] = __builtin_bit_cast(bf16x8, *(const GAS v4u*)(up + 32 * kb));
            f32x4 acc[8];
#pragma unroll
            for (int mb = 0; mb < 8; ++mb) acc[mb] = (f32x4){0.f, 0.f, 0.f, 0.f};
#pragma unroll
            for (int kb = 0; kb < 8; ++kb)
#pragma unroll
                for (int mb = 0; mb < 8; ++mb) { const bf16x8 Af = *(const LAS bf16x8*)(AP + (16 * mb + (lane & 15)) * S5_APP + 32 * kb + 8 * (lane >> 4)); acc[mb] = MFMA16(Uf[kb], Af, acc[mb]); if (mb == 7) asm volatile("" ::: "memory"); }
#pragma unroll
            for (int mp = 0; mp < 4; ++mp) {
                if (nb > 0) { const float r2 = zr[mp] * m13r[mp] - zi[mp] * m13i[mp], i2 = zr[mp] * m13i[mp] + zi[mp] * m13r[mp]; zr[mp] = r2; zi[mp] = i2; }
#pragma unroll
                for (int r = 0; r < 4; ++r) { const float r2 = zr[mp] * mur[mp] - zi[mp] * mui[mp] + acc[2 * mp][r], i2 = zr[mp] * mui[mp] + zi[mp] * mur[mp] + acc[2 * mp + 1][r]; zr[mp] = r2; zi[mp] = i2; } }
        }
        __syncthreads();
#pragma unroll
        for (int mp = 0; mp < 4; ++mp) { float xr = zr[mp] * wqr[mp] - zi[mp] * wqi[mp], xi = zr[mp] * wqi[mp] + zi[mp] * wqr[mp];
            xr += __shfl_xor(xr, 16); xi += __shfl_xor(xi, 16); xr += __shfl_xor(xr, 32); xi += __shfl_xor(xi, 32);
            if (lane < 16) E[wave * 64 + 16 * mp + lane] = (f32x2v){xr, xi}; }
    }
    __syncthreads();
    float sr = 0.f, si = 0.f;
    for (int w2 = 0; w2 < wave; ++w2) { const f32x2v e = E[w2 * 64 + lane]; const float nsr = pwr * sr - pwi * si + e.x, nsi = pwr * si + pwi * sr + e.y; sr = nsr; si = nsi; }
    bf16x8 Af[8];
#pragma unroll
    for (int mb = 0; mb < 8; ++mb) {
        const int nr_ = 8 * mb + ((lane & 15) >> 1), part = lane & 1; v4u w = (v4u){0u, 0u, 0u, 0u};
        if (lane < 32) { const f32x2v cf = *(const f32x2v*)(S5C + (size_t)(g * 64 + nr_) * 8 + 2);
            const float* pr = a.b_re + (size_t)(g * 64 + nr_) * 16 + 8 * (lane >> 4); const float* pi = a.b_im + (size_t)(g * 64 + nr_) * 16 + 8 * (lane >> 4);
            const f32x4 r0 = *(const f32x4*)pr, r1 = *(const f32x4*)(pr + 4), i0 = *(const f32x4*)pi, i1 = *(const f32x4*)(pi + 4);
            f32x4 v0, v1;
#pragma unroll
            for (int e = 0; e < 4; ++e) { v0[e] = part ? (cf.x * i0[e] + cf.y * r0[e]) : (cf.x * r0[e] - cf.y * i0[e]); v1[e] = part ? (cf.x * i1[e] + cf.y * r1[e]) : (cf.x * r1[e] - cf.y * i1[e]); }
            w.x = pk2(v0[0], v0[1]); w.y = pk2(v0[2], v0[3]); w.z = pk2(v1[0], v1[1]); w.w = pk2(v1[2], v1[3]); }
        Af[mb] = __builtin_bit_cast(bf16x8, w);
    }
    bf16x8 Cf[4];
#pragma unroll
    for (int kb = 0; kb < 4; ++kb) { const int p = lane & 15, n0 = 16 * kb + 4 * (lane >> 4);
        const f32x4 cr4 = *(const f32x4*)(a.c_re + (size_t)(g * 16 + p) * 64 + n0), ci4 = *(const f32x4*)(a.c_im + (size_t)(g * 16 + p) * 64 + n0);
        v4u w; w.x = pk2(cr4[0], -ci4[0]); w.y = pk2(cr4[1], -ci4[1]); w.z = pk2(cr4[2], -ci4[2]); w.w = pk2(cr4[3], -ci4[3]); Cf[kb] = __builtin_bit_cast(bf16x8, w); }
    const f32x4 d4 = *(const f32x4*)(a.s5_d + g * 16 + 4 * (lane >> 4));
    asm volatile("" ::: "memory");
    { v4u R[4];
#pragma unroll
      for (int i = 0; i < 4; ++i) R[i] = useg[lane + 64 * i];
#pragma unroll 1
      for (int ch = 0; ch < S5_NCH; ++ch) {
#pragma unroll
          for (int i = 0; i < 4; ++i) *(LAS v4u*)(Us + 16 * (lane + 64 * i)) = R[i];
          LDS_WAIT(); asm volatile("" ::: "memory");
          const int chn = ch < S5_NCH - 1 ? ch + 1 : ch;
#pragma unroll
          for (int i = 0; i < 4; ++i) R[i] = useg[256 * chn + lane + 64 * i];
#pragma unroll 1
          for (int sb = 0; sb < 8; ++sb) {
              v4u bw = *(const LAS v4u*)(Us + 512 * sb + (lane < 32 ? bf_off : 0)); if (lane >= 32) bw = (v4u){0u, 0u, 0u, 0u};
              const v2u uw = *(const LAS v2u*)(Us + 512 * sb + u4_off);
              s5_sub<true>(Af, Cf, d4, __builtin_bit_cast(bf16x8, bw), uw, sr, si, lbr, lbi, Bu, Sb, YS5 + (size_t)(tw + 128 * ch + 16 * sb) * D + g * 16, lane);
          }
      } }
    p3_stream_items(a, L, (LAS bf16*)(L + wave * S5_WLDS), vcu, G, lane);
    __syncthreads();
}

__device__ __forceinline__ void p3_mem_role(const Args& a, LAS unsigned char* L, int vcu, int G, int wave, int lane) {
    __syncthreads(); __syncthreads(); __syncthreads();
    p3_stream_items(a, L, (LAS bf16*)(L + S5W * S5_WLDS + (wave - S5W) * TR_BYTES), vcu, G, lane);
    __syncthreads();
}
static_assert(S5W * S5_WLDS + (NWAVES - S5W) * TR_BYTES <= S5_E && S5W * S5_WLDS >= 128 * S5_APP * 2, "P3 LDS map: S5 per-wave regions / AP image, then the memory role's transpose scratch, then E");
constexpr size_t WS_BT = 872 * MiB, WS_ACUM = 888 * MiB, WS_CF = 892 * MiB, WS_SC = 1000 * MiB;
static_assert(WS_SC + (size_t)64 * 8 * 128 * 128 * 2 <= WS_H && WS_ACUM + (size_t)M * NH * 4 <= WS_CF && WS_CF + (size_t)64 * 8 * 16384 * 2 <= WS_SC, "ssd scratch map");
constexpr size_t WS_SSQ = 908 * MiB, WS_RT = 916 * MiB;
constexpr int SP_ROW = 136;
__device__ __forceinline__ void ssd_prep_dt(const Args& a, int item, LAS float* tot, int tid) {
    const float* DTP = a.out; float* DTS = (float*)(a.ws + WS_DTS); float* ACUM = (float*)(a.ws + WS_ACUM);
    const int c = item >> 2, h = 32 * (item & 3) + (tid & 31), q = tid >> 5;
    const float av = -expf(a.a_log[h]) * 1.44269504088896f, bias = a.dt_bias[h];
    float raw[8];
#pragma unroll
    for (int i = 0; i < 8; ++i) { const size_t idx = (size_t)(128 * c + 8 * q + i) * NH + h; float r = bias;
#pragma unroll
        for (int ks = 0; ks < 8; ++ks) r += DTP[(size_t)ks * M * NH + idx];
        raw[i] = r; }
    float loc[8]; float run = 0.f;
#pragma unroll
    for (int i = 0; i < 8; ++i) { const float dt = softplus_f(raw[i]); raw[i] = dt; run += dt * av; loc[i] = run; }
    { float* dp = DTS + (size_t)h * M + 128 * c + 8 * q; *(f32x4*)dp = (f32x4){raw[0], raw[1], raw[2], raw[3]}; *(f32x4*)(dp + 4) = (f32x4){raw[4], raw[5], raw[6], raw[7]}; }
    tot[q * 32 + (tid & 31)] = run;
    __syncthreads();
    float off = 0.f;
#pragma unroll
    for (int q2 = 0; q2 < 15; ++q2) off += (q2 < q) ? tot[q2 * 32 + (tid & 31)] : 0.f;
    { float* ap = ACUM + (size_t)h * M + 128 * c + 8 * q; *(f32x4*)ap = (f32x4){loc[0] + off, loc[1] + off, loc[2] + off, loc[3] + off}; *(f32x4*)(ap + 4) = (f32x4){loc[4] + off, loc[5] + off, loc[6] + off, loc[7] + off}; }
    __syncthreads();
}
template <int STAGE> __device__ __forceinline__ void ssd_prep_cg(const Args& a, int c, int g, LAS unsigned char* L, int tid, int wave, int lane) {
    const bf16* XBC = (const bf16*)(a.ws + WS_XBC); bf16* SC = (bf16*)(a.ws + WS_SC) + (size_t)(c * 8 + g) * 16384; bf16* BT = (bf16*)(a.ws + WS_BT) + (size_t)(c * 8 + g) * 16384; bf16* CF = (bf16*)(a.ws + WS_CF) + (size_t)(c * 8 + g) * 16384;
    LAS bf16* Bs = (LAS bf16*)L; LAS bf16* Cs = (LAS bf16*)(L + 128 * SP_ROW * 2);
    const int o = tid & 15;
    if constexpr (STAGE == 0) {
#pragma unroll
    for (int mat = 0; mat < 2; ++mat) {
        const int col0 = DI + mat * (NG * NS) + g * NS + 8 * o;
        f32x4 w0[4], w1[4];
#pragma unroll
        for (int k = 0; k < 4; ++k) { w0[k] = *(const f32x4*)(a.conv_w + k * CONVD + col0); w1[k] = *(const f32x4*)(a.conv_w + k * CONVD + col0 + 4); }
        const f32x4 b0 = *(const f32x4*)(a.conv_b + col0), b1 = *(const f32x4*)(a.conv_b + col0 + 4);
#pragma unroll
        for (int i = 0; i < 4; ++i) { const int tl = (tid >> 4) + 32 * i, t = 128 * c + tl;
            f32x4 acc0 = b0, acc1 = b1;
#pragma unroll
            for (int k = 0; k < 4; ++k) { const int tt = t - 3 + k;
                if (tt >= 0) { f32x4 r0, r1; pg8::unpack8(*(const GAS v4u*)(XBC + (size_t)tt * CONVD + col0), r0, r1); acc0 = acc0 + r0 * w0[k]; acc1 = acc1 + r1 * w1[k]; } }
#pragma unroll
            for (int e = 0; e < 4; ++e) { acc0[e] = pg8::silu_f(acc0[e]); acc1[e] = pg8::silu_f(acc1[e]); }
            v4u ov; ov.x = pk2(acc0.x, acc0.y); ov.y = pk2(acc0.z, acc0.w); ov.z = pk2(acc1.x, acc1.y); ov.w = pk2(acc1.z, acc1.w);
            *(LAS v4u*)((mat ? Cs : Bs) + tl * SP_ROW + 8 * o) = ov; }
    }
    } else {
    { f32x4 acc[8];
#pragma unroll
      for (int sb = 0; sb < 8; ++sb) acc[sb] = (f32x4){0.f, 0.f, 0.f, 0.f};
#pragma unroll
      for (int kb = 0; kb < 4; ++kb) { const bf16x8 cf = *(const LAS bf16x8*)(Cs + (16 * wave + (lane & 15)) * SP_ROW + 32 * kb + 8 * (lane >> 4));
          *(GAS v4u*)(CF + (size_t)((wave * 4 + kb) * 64 + lane) * 8) = __builtin_bit_cast(v4u, cf);
#pragma unroll
          for (int sb = 0; sb < 8; ++sb) { const bf16x8 bfr = *(const LAS bf16x8*)(Bs + (16 * sb + (lane & 15)) * SP_ROW + 32 * kb + 8 * (lane >> 4)); acc[sb] = MFMA16(bfr, cf, acc[sb]); } }
#pragma unroll
      for (int sb = 0; sb < 8; ++sb) { v2u ov; ov.x = pk2(acc[sb][0], acc[sb][1]); ov.y = pk2(acc[sb][2], acc[sb][3]);
          const int q = lane >> 4, lanep = (lane & 15) + 16 * (2 * (sb & 1) + (q >> 1));
          *(GAS v2u*)(SC + (size_t)((wave * 4 + (sb >> 1)) * 64 + lanep) * 8 + 4 * (q & 1)) = ov; } }
#pragma unroll
    for (int kb = 0; kb < 4; ++kb) { unsigned short v[8];
#pragma unroll
        for (int e = 0; e < 8; ++e) v[e] = Bs[(32 * kb + 8 * (lane >> 4) + e) * SP_ROW + 16 * wave + (lane & 15)];
        v4u ov; ov.x = v[0] | ((unsigned)v[1] << 16); ov.y = v[2] | ((unsigned)v[3] << 16); ov.z = v[4] | ((unsigned)v[5] << 16); ov.w = v[6] | ((unsigned)v[7] << 16);
        *(GAS v4u*)(BT + (size_t)((wave * 4 + kb) * 64 + lane) * 8) = ov; }
    }
}
constexpr int PREP_LDS = 2 * 128 * SP_ROW * 2;
constexpr int SM_XD = 0, SM_XW = 8192, SM_XP = 16384, SM_ZP = 24576, SM_AC = 32768, SM_XE = 33280, SM_BUF = 41472, SM_SB = 2 * SM_BUF, SM_SBSZ = 8704;
typedef short s16x4 __attribute__((ext_vector_type(4)));
__device__ __forceinline__ bf16x8 ssd_tr_frag(const LAS unsigned char* img, int kb, int pb, int lane) {
    const LAS unsigned char* ad = img + (32 * kb + 8 * (lane >> 4) + ((lane & 15) >> 2)) * 64 + (16 * pb + 4 * (lane & 3)) * 2;
    const s16x4 lo = __builtin_amdgcn_ds_read_tr16_b64_v4i16((LAS s16x4*)ad), hi = __builtin_amdgcn_ds_read_tr16_b64_v4i16((LAS s16x4*)(ad + 4 * 64));
    return __builtin_shufflevector(lo, hi, 0, 1, 2, 3, 4, 5, 6, 7);
}
__device__ __forceinline__ bf16x8 ssd_tr_frag_y(const LAS unsigned char* img, int kb, int pb, int lane) {
    const LAS unsigned char* ad = img + (32 * kb + 8 * (lane >> 4) + ((lane & 15) >> 2)) * 64 + (8 * (lane & 3) + 4 * pb) * 2;
    const s16x4 lo = __builtin_amdgcn_ds_read_tr16_b64_v4i16((LAS s16x4*)ad), hi = __builtin_amdgcn_ds_read_tr16_b64_v4i16((LAS s16x4*)(ad + 4 * 64));
    return __builtin_shufflevector(lo, hi, 0, 1, 2, 3, 4, 5, 6, 7);
}
struct SsdStage { v4u x, z; float dt, ac, acend, acb; };
__device__ __forceinline__ void ssd_stage_load(SsdStage& s, const bf16* XC, const bf16* MZ, const float* DTS, const float* ACUM, int c, int h, int ph, int tid) {
    const int t = 128 * c + (tid >> 2), piece = tid & 3;
    s.x = __builtin_nontemporal_load((const GAS v4u*)(XC + (size_t)t * CONVD + h * HD + 32 * ph + 8 * piece));
    s.z = __builtin_nontemporal_load((const GAS v4u*)(MZ + (size_t)t * DI + h * HD + 32 * ph + 8 * piece));
    s.dt = DTS[(size_t)h * M + t]; s.ac = ACUM[(size_t)h * M + t]; s.acend = ACUM[(size_t)h * M + 128 * c + 127]; s.acb = ACUM[(size_t)h * M + 128 * c + ((tid >> 2) | 31)];
}
__device__ __forceinline__ void ssd_stage_store(const SsdStage& s, LAS unsigned char* buf, int tid) {
    const int tl = tid >> 2, piece = tid & 3;
    const float te = __builtin_amdgcn_exp2f(s.acend - s.ac), tb = __builtin_amdgcn_exp2f(s.acb - s.ac);
    const unsigned xs[4] = {s.x.x, s.x.y, s.x.z, s.x.w}; unsigned d[4], w[4], eb[4];
#pragma unroll
    for (int e2 = 0; e2 < 4; ++e2) { const float x0 = bf_lo(xs[e2]) * s.dt, x1 = bf_hi(xs[e2]) * s.dt; d[e2] = pk2(x0, x1); w[e2] = pk2(x0 * te, x1 * te); eb[e2] = pk2(x0 * tb, x1 * tb); }
    *(LAS v4u*)(buf + SM_XE + tl * 64 + 16 * piece) = (v4u){eb[0], eb[1], eb[2], eb[3]};
    *(LAS v4u*)(buf + SM_XD + tl * 64 + 16 * piece) = (v4u){d[0], d[1], d[2], d[3]};
    *(LAS v4u*)(buf + SM_XW + tl * 64 + 16 * piece) = (v4u){w[0], w[1], w[2], w[3]};
    *(LAS v4u*)(buf + SM_XP + tl * 64 + 16 * piece) = s.x;
    *(LAS v4u*)(buf + SM_ZP + tl * 64 + 16 * piece) = s.z;
    if (piece == 0) *(LAS float*)(buf + SM_AC + 4 * tl) = s.ac;
}
struct SsdFrags { bf16x8 sc[3], scd, cc[4], bt[4]; };
__device__ __forceinline__ void ssd_frag_load(SsdFrags& f, const bf16* SC, const bf16* CF, const bf16* BT, int c, int g, int wave, int lane) {
    const size_t base = ((size_t)((c * 8 + g) * 8 + wave) * 4 * 64 + lane) * 8; const int kd = wave >> 1;
#pragma unroll
    for (int kb = 0; kb < 4; ++kb) { if (kb < 3) { if (kb < kd) f.sc[kb] = __builtin_bit_cast(bf16x8, *(const GAS v4u*)(SC + base + kb * 512)); } else f.scd = __builtin_bit_cast(bf16x8, *(const GAS v4u*)(SC + base + kd * 512));
        f.cc[kb] = __builtin_bit_cast(bf16x8, *(const GAS v4u*)(CF + base + kb * 512)); f.bt[kb] = __builtin_bit_cast(bf16x8, *(const GAS v4u*)(BT + base + kb * 512)); }
}
#define SSD_BAR() do { LDS_WAIT(); asm volatile("" ::: "memory"); __builtin_amdgcn_s_barrier(); asm volatile("" ::: "memory"); } while (0)
template <int DBG> __device__ __forceinline__ void ssd_chunk(const SsdFrags& fr, SsdFrags& frn, const SsdStage& sgs, SsdStage& sgl, f32x4 (&st)[2], int c, int cn, int cl, const bf16* XC, const bf16* MZ, const float* DTS, const float* ACUM, const bf16* SC, const bf16* CF, const bf16* BT, bf16* YSSD, float* SSQ,
                                          int h, int ph, int g, float Dh, LAS unsigned char* L, int tid, int wave, int lane, bool late) {
    LAS unsigned char* buf = L + (c & 1) * SM_BUF; LAS unsigned char* nbuf = L + ((c + 1) & 1) * SM_BUF;
    const LAS bf16* SBo = (const LAS bf16*)(L + SM_SB + (c & 1) * SM_SBSZ); LAS bf16* SBn = (LAS bf16*)(L + SM_SB + ((c + 1) & 1) * SM_SBSZ);
    const LAS unsigned char* XD = buf + SM_XD; const LAS unsigned char* XW = buf + SM_XW; const LAS float* AC = (const LAS float*)(buf + SM_AC);
    if (!(DBG & 2)) ssd_frag_load(frn, SC, CF, BT, cn, g, wave, lane);
    if (!(DBG & 4)) ssd_stage_load(sgl, XC, MZ, DTS, ACUM, cl, h, ph, tid);
    const int trow = 16 * wave + (lane & 15), ko = 8 * (lane >> 4), kd = wave >> 1;
    auto state_and_stage = [&]() __attribute__((always_inline)) {
    { const float dec = __builtin_amdgcn_exp2f(AC[127]); st[0] = st[0] * dec; st[1] = st[1] * dec;
      if (!(DBG & 16))
#pragma unroll
      for (int kb = 0; kb < 4; ++kb)
#pragma unroll
          for (int pb = 0; pb < 2; ++pb) { const bf16x8 Bf = ssd_tr_frag(XW, kb, pb, lane); st[pb] = MFMA16(fr.bt[kb], Bf, st[pb]); }
#pragma unroll
      for (int pb = 0; pb < 2; ++pb) { v2u ov; ov.x = pk2(st[pb][0], st[pb][1]); ov.y = pk2(st[pb][2], st[pb][3]); *(LAS v2u*)(SBn + (16 * pb + (lane & 15)) * SP_ROW + 16 * wave + 4 * (lane >> 4)) = ov; } }
    if (!(DBG & 8)) ssd_stage_store(sgs, nbuf, tid); };
    if (late) state_and_stage();
    const LAS unsigned char* XE = buf + SM_XE;
    bf16x8 Sf[4][2];
#pragma unroll
    for (int kb = 0; kb < 4; ++kb)
#pragma unroll
        for (int pb = 0; pb < 2; ++pb) Sf[kb][pb] = *(const LAS bf16x8*)(SBo + (8 * ((lane & 15) >> 2) + 4 * pb + (lane & 3)) * SP_ROW + 32 * kb + ko);
    const float act = AC[trow];
    const f32x4 as0 = *(const LAS f32x4*)(AC + 32 * kd + ko), as1 = *(const LAS f32x4*)(AC + 32 * kd + ko + 4);
    const float ae0 = AC[31], ae1 = AC[63], ae2 = AC[95];
    const v4u xv = *(const LAS v4u*)(buf + SM_XP + trow * 64 + 16 * (lane >> 4)), zv = *(const LAS v4u*)(buf + SM_ZP + trow * 64 + 16 * (lane >> 4));
    const v2u xw[2] = {(v2u){xv.x, xv.y}, (v2u){xv.z, xv.w}}, zw[2] = {(v2u){zv.x, zv.y}, (v2u){zv.z, zv.w}};
    const f32x4 zero4 = (f32x4){0.f, 0.f, 0.f, 0.f};
    f32x4 accD[2] = {zero4, zero4}, accO[2] = {zero4, zero4}, P[3][2];
    if (!(DBG & 16))
#pragma unroll
    for (int kb = 0; kb < 4; ++kb)
#pragma unroll
        for (int pb = 0; pb < 2; ++pb) accO[pb] = MFMA16(Sf[kb][pb], fr.cc[kb], accO[pb]);
#pragma unroll
    for (int kb = 0; kb < 3; ++kb) if (kb < kd && !(DBG & 16)) {
#pragma unroll
        for (int pb = 0; pb < 2; ++pb) P[kb][pb] = MFMA16(ssd_tr_frag_y(XE, kb, pb, lane), fr.sc[kb], zero4); }
    if (!(DBG & 16)) { const v4u sw = __builtin_bit_cast(v4u, fr.scd); const unsigned sws[4] = {sw.x, sw.y, sw.z, sw.w}; unsigned ow[4];
      const int dl = 16 * (wave & 1) + (lane & 15) - ko;
#pragma unroll
      for (int e2 = 0; e2 < 4; ++e2) { const float a0 = e2 < 2 ? as0[2 * e2] : as1[2 * e2 - 4], a1 = e2 < 2 ? as0[2 * e2 + 1] : as1[2 * e2 - 3];
          float v0 = bf_lo(sws[e2]) * __builtin_amdgcn_exp2f(act - a0), v1 = bf_hi(sws[e2]) * __builtin_amdgcn_exp2f(act - a1);
          v0 = (2 * e2 <= dl) ? v0 : 0.f; v1 = (2 * e2 + 1 <= dl) ? v1 : 0.f;
          ow[e2] = pk2(v0, v1); }
      const bf16x8 Lf = __builtin_bit_cast(bf16x8, ((v4u){ow[0], ow[1], ow[2], ow[3]}));
#pragma unroll
      for (int pb = 0; pb < 2; ++pb) { const bf16x8 Xf = ssd_tr_frag_y(XD, kd, pb, lane); accD[pb] = MFMA16(Xf, Lf, accD[pb]); } }
    { const float ea = __builtin_amdgcn_exp2f(act); float ssq = 0.f;
      const float aes[3] = {ae0, ae1, ae2};
#pragma unroll
      for (int kb = 0; kb < 3; ++kb) if (kb < kd && !(DBG & 16)) { const float r = __builtin_amdgcn_exp2f(act - aes[kb]);
#pragma unroll
          for (int pb = 0; pb < 2; ++pb) accD[pb] = accD[pb] + r * P[kb][pb]; }
      unsigned yo[4];
#pragma unroll
      for (int pb = 0; pb < 2; ++pb) {
          const float y0 = (accD[pb][0] + ea * accO[pb][0] + Dh * bf_lo(xw[pb].x)) * bf_lo(zw[pb].x), y1 = (accD[pb][1] + ea * accO[pb][1] + Dh * bf_hi(xw[pb].x)) * bf_hi(zw[pb].x);
          const float y2 = (accD[pb][2] + ea * accO[pb][2] + Dh * bf_lo(xw[pb].y)) * bf_lo(zw[pb].y), y3 = (accD[pb][3] + ea * accO[pb][3] + Dh * bf_hi(xw[pb].y)) * bf_hi(zw[pb].y);
          ssq += (y0 * y0 + y1 * y1) + (y2 * y2 + y3 * y3);
          yo[2 * pb] = pk2(y0, y1); yo[2 * pb + 1] = pk2(y2, y3); }
      if (!(DBG & 1)) __builtin_nontemporal_store(((v4u){yo[0], yo[1], yo[2], yo[3]}), (GAS v4u*)(YSSD + (size_t)(128 * c + trow) * DI + h * HD + 32 * ph + 8 * (lane >> 4)));
      ssq += __shfl_xor(ssq, 16); ssq += __shfl_xor(ssq, 32);
      if (lane < 16 && !(DBG & 32)) SSQ[((size_t)(8 * c + wave) * 256 + 2 * h + ph) * 16 + lane] = ssq; }
    if (!late) state_and_stage();
    SSD_BAR();
}
template <int DBG> __device__ __forceinline__ void ssd_main_item(const Args& a, int item, LAS unsigned char* L, int tid, int wave, int lane) {
    const bf16* XC = (const bf16*)(a.ws + WS_XC); const bf16* MZ = (const bf16*)(a.ws + WS_MZ); const float* DTS = (const float*)(a.ws + WS_DTS); const float* ACUM = (const float*)(a.ws + WS_ACUM);
    const bf16* SC = (const bf16*)(a.ws + WS_SC); const bf16* BT = (const bf16*)(a.ws + WS_BT); const bf16* CF = (const bf16*)(a.ws + WS_CF); bf16* YSSD = (bf16*)(a.ws + WS_YSSD); float* SSQ = (float*)(a.ws + WS_SSQ);
    const int h = item >> 1, ph = item & 1, g = h >> 4; const float Dh = a.m2_d[h];
    const int wave_hw = wave; wave = wave_hw < 4 ? 7 - wave_hw : wave_hw - 4;
    for (int i = tid; i < SM_SBSZ / 4; i += NWAVES * 64) *(LAS unsigned*)(L + SM_SB + 4 * i) = 0u;
    SsdStage sgE, sgO; SsdFrags frA, frB;
    ssd_stage_load(sgE, XC, MZ, DTS, ACUM, 0, h, ph, tid); ssd_frag_load(frA, SC, CF, BT, 0, g, wave, lane);
    ssd_stage_load(sgO, XC, MZ, DTS, ACUM, 1, h, ph, tid);
    ssd_stage_store(sgE, L, tid);
    f32x4 st[2] = {(f32x4){0.f, 0.f, 0.f, 0.f}, (f32x4){0.f, 0.f, 0.f, 0.f}};
    __syncthreads();
    const bool late = wave_hw >= 4;
#pragma unroll 1
    for (int c = 0; c < 64; c += 2) {
        ssd_chunk<DBG>(frA, frB, sgO, sgE, st, c, c + 1, c + 2 < 64 ? c + 2 : 63, XC, MZ, DTS, ACUM, SC, CF, BT, YSSD, SSQ, h, ph, g, Dh, L, tid, wave, lane, late);
        ssd_chunk<DBG>(frB, frA, sgE, sgO, st, c + 1, c + 2 < 64 ? c + 2 : 63, c + 3 < 64 ? c + 3 : 63, XC, MZ, DTS, ACUM, SC, CF, BT, YSSD, SSQ, h, ph, g, Dh, L, tid, wave, lane, late);
    }
    __syncthreads();
}

__device__ __forceinline__ void ssd_norm_stats(const Args& a, size_t gt, size_t NT) {
    const float* SSQ = (const float*)(a.ws + WS_SSQ); float* RT = (float*)(a.ws + WS_RT);
    for (size_t idx = gt; idx < (size_t)M * NG; idx += NT) {
        const int t = (int)(idx >> 6) * 8 + (int)(idx & 7), g = (int)(idx >> 3) & 7;
        const float* sp = SSQ + ((size_t)(t >> 4) * 256 + 32 * g) * 16 + (t & 15);
        float s = 0.f;
#pragma unroll 8
        for (int j = 0; j < 32; ++j) s += sp[j * 16];
        const float r = 1.0f / sqrtf(s * (1.0f / 1024.0f) + EPS);
        const float rn = __shfl_down(r, 8);
        RT[(size_t)t * 8 + g] = (g == 7) ? r : r / rn;
    }
}
__global__ void __launch_bounds__(NWAVES * 64, 2) hyb_fwd(Args args) {
    extern __shared__ __attribute__((aligned(16))) unsigned char lds[];
    LAS unsigned char* L = (LAS unsigned char*)lds;
    volatile LAS unsigned* MISC = (volatile LAS unsigned*)(L + MISC_OFF);
    const int tid = threadIdx.x, lane = tid & 63, wave = __builtin_amdgcn_readfirstlane(tid >> 6);
    const int G = gridDim.x; const int bx = blockIdx.x; const int vcu = (G % 8 == 0) ? (bx % 8) * (G / 8) + bx / 8 : bx;
    const int gw = vcu * NWAVES + wave, NGW = G * NWAVES;
    gu32* ctl = (gu32*)(args.ws + WS_CTL);
    for (int u = tid; u < (LDS_BYTES - LDSCTL_OFF) / 4; u += NWAVES * 64) ((LAS unsigned*)(L + LDSCTL_OFF))[u] = 0u;
    __syncthreads();
    XcdBarrier bar; bar.bar = (unsigned*)(ctl + CW_BAR); bar.x = 0; bar.st = nullptr;
    if (N_LAUNCHES == 1) bar = xcd_barrier_post((unsigned*)(ctl + CW_BAR), MISC + 8);
#define GRID_BAR() do { if (N_LAUNCHES == 1) xcd_barrier(bar); } while (0)
    const int lo = args.ph_lo, hi = args.ph_hi;
#define IN(k) (lo <= (k) && (k) < hi)
#define BOTH(k) (IN(k) && IN((k) + 1))
#if defined(PROBE_PHASE)
#define PROBE_DBG(x) (x)
#else
#define PROBE_DBG(x) 0
#endif
#define LAUNDER() int lane_p = lane, tid_p = tid; asm volatile("" : "+v"(lane_p), "+v"(tid_p))

    if (IN(0)) {
        LAUNDER();
        p0_gemv(args.c, args.w_ada, (float*)(args.ws + WS_MODP), (LAS float*)(L + RING_OFF), vcu, G, tid_p);
        p0_weights_in(args, (LAS bf16*)(L + RING_OFF + wave * 16384), gw, NGW, lane_p);
        s5_consts(args, (size_t)gw * 64 + lane_p, (size_t)NGW * 64);
        if (BOTH(0)) GRID_BAR();
    }
    if (IN(1)) {
        LAUNDER();
        p1_h(args, (LAS float*)(L + RING_OFF), (LAS float*)(L + RING_OFF + 16384), gw, NGW, tid_p, lane_p);
        if (BOTH(1)) GRID_BAR();
    }
    if (IN(2)) {
        { pg8::Gemm g{(const bf16*)(args.ws + WS_H), (const bf16*)(args.ws + WS_WIN), M, NMAIN, D, D}; pg8::StaticOrder S; S.init(M, NMAIN, G, bx);
          pg8::EpiProj E{(bf16*)(args.ws + WS_U), (bf16*)(args.ws + WS_SZ), (bf16*)(args.ws + WS_MZ), (bf16*)(args.ws + WS_XBC), (bf16*)(args.ws + WS_G1), (bf16*)(args.ws + WS_G2)};
          pg8::gemm_phase<pg8::EpiProj, pg8::StaticOrder, PG8_ALIGN, PG8_SP2>(L + RING_OFF, g, S, E); }
        { pg8::Gemm g{(const bf16*)(args.ws + WS_H), (const bf16*)(args.ws + WS_WIN) + (size_t)NMAIN * D, M, 8 * 256, 512, D}; pg8::StaticOrder S; S.init(M, 8 * 256, G, bx);
          pg8::EpiDTP E{args.out};
          pg8::gemm_phase<pg8::EpiDTP, pg8::StaticOrder, PG8_ALIGN, PG8_SP2, true>(L + RING_OFF, g, S, E); }
        if (BOTH(2)) GRID_BAR();
    }
    if (IN(3)) {
        LAUNDER();
        const int sub = args.sub;
        if (tid_p == 0) *(LAS unsigned*)(L + RING_OFF + P3_CNT_OFF) = (sub == 5) ? 0x100000u : 0u;
        if (sub == 0 || sub == 2) for (int it = vcu; it < 64 * NG; it += 2 * G) {
            const int it2 = it + G; const bool two = it2 < 64 * NG;
            ssd_prep_cg<0>(args, it >> 3, it & 7, L + RING_OFF, tid_p, wave, lane_p);
            if (two) ssd_prep_cg<0>(args, it2 >> 3, it2 & 7, L + RING_OFF + PREP_LDS, tid_p, wave, lane_p);
            __syncthreads();
            ssd_prep_cg<1>(args, it >> 3, it & 7, L + RING_OFF, tid_p, wave, lane_p);
            if (two) ssd_prep_cg<1>(args, it2 >> 3, it2 & 7, L + RING_OFF + PREP_LDS, tid_p, wave, lane_p);
            __syncthreads(); }
        if (sub == 0 || sub == 3) for (int it = vcu; it < 64 * 4; it += G) ssd_prep_dt(args, it, (LAS float*)(L + RING_OFF), tid_p);
        if (sub == 0 || sub == 1 || sub == 5) for (int g5 = vcu; g5 < S5G; g5 += G) {
            if (wave < S5W) s5_fast_group(args, g5, L + RING_OFF, vcu, G, wave, lane_p);
            else p3_mem_role(args, L + RING_OFF, vcu, G, wave, lane_p); }
        if (BOTH(3)) GRID_BAR();
    }
    if (IN(4)) { LAUNDER(); for (int it = vcu; it < NH * 2; it += G) {
#if defined(PROBE_PHASE) && PROBE_PHASE == 4
            if (args.sub) ssd_main_item<PROBE_SUB>(args, it, L + RING_OFF, tid_p, wave, lane_p); else
#endif
            ssd_main_item<0>(args, it, L + RING_OFF, tid_p, wave, lane_p); } if (BOTH(4)) GRID_BAR(); }
    if (IN(5)) { LAUNDER(); ssd_norm_stats(args, (size_t)gw * 64 + lane_p, (size_t)NGW * 64); }
    if (IN(6)) {
        pg8::Gemm g{(const bf16*)(args.ws + WS_YS5), (const bf16*)(args.ws + WS_WGLU), M, 8192, D, D}; pg8::StaticOrder S; S.init(M, 8192, G, bx);
        pg8::EpiGlu E{(const bf16*)(args.ws + WS_SZ), args.b_glu, (bf16*)(args.ws + WS_YS5G)};
        pg8::gemm_phase<pg8::EpiGlu, pg8::StaticOrder, PG8_ALIGN, PG8_SP2>(L + RING_OFF, g, S, E);
        if (BOTH(6)) GRID_BAR();
    }
    if (IN(7)) {
        pg8::Gemm g{(const bf16*)(args.ws + WS_YS5G), (const bf16*)(args.ws + WS_WBRS), M, D, D, D}; pg8::StaticOrder S; S.init(M, D, G, bx);
        pg8::EpiBrS E{(const bf16*)(args.ws + WS_G1), (bf16*)(args.ws + WS_T1)};
        pg8::gemm_phase<pg8::EpiBrS, pg8::StaticOrder, PG8_ALIGN, PG8_SP2>(L + RING_OFF, g, S, E);
    }
    if (IN(8)) {
        pg8::Gemm g{(const bf16*)(args.ws + WS_YSSD), (const bf16*)(args.ws + WS_WBRM), M, D, DI, DI}; pg8::StaticOrder S; S.init(M, D, G, bx);
        pg8::EpiBrM E{(const bf16*)(args.ws + WS_G2), (const bf16*)(args.ws + WS_T1), (bf16*)(args.ws + WS_MERGED), (const float*)(args.ws + WS_RT)};
        pg8::gemm_phase<pg8::EpiBrM, pg8::StaticOrder, PG8_ALIGN, PG8_SP2>(L + RING_OFF, g, S, E);
        if (BOTH(8)) GRID_BAR();
    }
    if (IN(9)) {
        pg8::Gemm g{(const bf16*)(args.ws + WS_MERGED), (const bf16*)(args.ws + WS_WOUT), M, D, D, D}; pg8::StaticOrder S; S.init(M, D, G, bx);
        pg8::EpiOut E{args.x, (const float*)(args.ws + WS_GATE), (bf16*)(args.ws + WS_X2), (float*)(args.ws + WS_SS)};
        pg8::gemm_phase<pg8::EpiOut, pg8::StaticOrder, PG8_ALIGN, PG8_SP2>(L + RING_OFF, g, S, E);
        if (BOTH(9)) GRID_BAR();
    }
    if (IN(10)) { LAUNDER(); final_norm(args, gw, NGW, lane_p); }

#if defined(DBG_STOP)
    if (IN(NPH)) {
        const size_t gt = (size_t)gw * 64 + lane, NT = (size_t)NGW * 64; const size_t R = (size_t)8 << 20;
        const unsigned char* b0 = args.ws + DBG_B0; const unsigned char* b1 = args.ws + DBG_B1; const unsigned char* b2 = args.ws + DBG_B2; const unsigned char* b3 = args.ws + DBG_B3;
        for (size_t i = gt; i < R; i += NT) {
            float s0 = 0.f, s1 = 0.f, s2 = 0.f, s3 = 0.f;
            for (size_t j = i; j < (size_t)DBG_N0; j += R) s0 += DBG_F0 ? ((const float*)b0)[j] : bf2f(((const bf16*)b0)[j]);
            for (size_t j = i; j < (size_t)DBG_N1; j += R) s1 += DBG_F1 ? ((const float*)b1)[j] : bf2f(((const bf16*)b1)[j]);
            for (size_t j = i; j < (size_t)DBG_N2; j += R) s2 += DBG_F2 ? ((const float*)b2)[j] : bf2f(((const bf16*)b2)[j]);
            for (size_t j = i; j < (size_t)DBG_N3; j += R) s3 += DBG_F3 ? ((const float*)b3)[j] : bf2f(((const bf16*)b3)[j]);
            args.out[i] = s0 * 1e9f; args.out[R + i] = s1 * 1e6f; args.out[2 * R + i] = s2 * 1e3f; args.out[3 * R + i] = s3;
        }
    }
#endif
#undef IN
#undef BOTH
}

extern "C" void kernel_launch(void* const* d_in, const int* in_sizes, int n_in, void* d_out, int out_size, void* d_ws, size_t ws_size, hipStream_t stream) {
    static int grid = 0;
    if (grid == 0) {
        if (n_in != 26 || in_sizes[0] != M * D || out_size != M * D || ws_size < WS_END) { fprintf(stderr, "kernel_launch: built for 26 inputs, x/out of %d floats, >= %zu bytes of workspace; got n_in %d, in0 %d, out %d, ws %zu; nothing launched\n", M * D, (size_t)WS_END, n_in, n_in > 0 ? in_sizes[0] : -1, out_size, ws_size); grid = -1; return; }
        int dev = 0, cus = 0, per_cu = 0;
        if (hipGetDevice(&dev) != hipSuccess || hipDeviceGetAttribute(&cus, hipDeviceAttributeMultiprocessorCount, dev) != hipSuccess) { fprintf(stderr, "kernel_launch: hipGetDevice / hipDeviceGetAttribute failed\n"); grid = -1; return; }
        if (hipFuncSetAttribute((const void*)hyb_fwd, hipFuncAttributeMaxDynamicSharedMemorySize, LDS_BYTES) != hipSuccess) { fprintf(stderr, "kernel_launch: hipFuncSetAttribute failed\n"); grid = -1; return; }
        if (hipOccupancyMaxActiveBlocksPerMultiprocessor(&per_cu, (const void*)hyb_fwd, NWAVES * 64, LDS_BYTES) != hipSuccess || per_cu < 1)
            fprintf(stderr, "kernel_launch: note: the occupancy query reports %d workgroups per CU\n", per_cu);
        (void)hipGetLastError();
        grid = cus;
    }
    if (grid < 0) return;
    if (hipMemsetAsync((char*)d_ws + WS_CTL, 0, CTL_ZERO_BYTES, stream) != hipSuccess) { fprintf(stderr, "kernel_launch: hipMemsetAsync failed\n"); return; }
    Args a{};
    const float** ap = (const float**)&a;
    for (int i = 0; i < 26; ++i) ap[i] = (const float*)d_in[i];
    a.out = (float*)d_out; a.ws = (unsigned char*)d_ws;
#if defined(DBG_STOP)
    const int nl = DBG_STOP + 2;
#else
    const int nl = N_LAUNCHES;
#endif
    for (int li = 0; li < nl; ++li) {
        a.ph_lo = (N_LAUNCHES == 1) ? 0 : li; a.ph_hi = (N_LAUNCHES == 1) ? NPH : li + 1;
#if defined(DBG_STOP)
        if (li == nl - 1) { a.ph_lo = NPH; a.ph_hi = NPH + 1; }
#endif
        hipLaunchKernelGGL(hyb_fwd, dim3(grid), dim3(NWAVES * 64), LDS_BYTES, stream, a);
        const hipError_t le = hipPeekAtLastError();
        if (le != hipSuccess) { fprintf(stderr, "kernel_launch: launch %d failed: %s\n", li, hipGetErrorName(le)); break; }
    }
#if defined(PROBE_PHASE)
    a.ph_lo = PROBE_PHASE; a.ph_hi = PROBE_PHASE + 1; a.sub = PROBE_SUB;
    hipLaunchKernelGGL(hyb_fwd, dim3(grid), dim3(NWAVES * 64), LDS_BYTES, stream, a);
#endif
}
```

```cpp
#include <hip/hip_runtime.h>
#include <cstdio>
#include <cstdint>
namespace pg8 {
#define PG8_LAS __attribute__((address_space(3)))
typedef unsigned short bf16_t;
typedef short bf16x8 __attribute__((ext_vector_type(8)));
typedef float f32x4 __attribute__((ext_vector_type(4)));
typedef unsigned u32x4 __attribute__((ext_vector_type(4)));
constexpr int BM = 256, BK = 64, HALF = 128, HTB = HALF * BK * 2  , STAGE_BYTES = 8 * HTB, NXCD = 8, WGM = 4;

__host__ __device__ __forceinline__ int lds_byte(int r, int c) { const int st = (r >> 4) * 2 + (c >> 5), rr = r & 15, cc = c & 31, ob = rr * 64 + cc * 2; return st * 1024 + (ob ^ (((ob >> 9) & 1) << 5)); }
__host__ __device__ __forceinline__ void stage_rc(int b, int& R, int& C) { const int st = b / 1024, sb = b % 1024, swz = sb ^ (((sb >> 9) & 1) << 5); R = (st >> 1) * 16 + swz / 64; C = (st & 1) * 32 + (swz % 64) / 2; }
__host__ __device__ __forceinline__ int perm32(int rho) { const int n = rho >> 4, i = rho & 15; return 8 * (i >> 2) + 4 * n + (i & 3); }

struct Unit { int pm, pn; };
struct Gemm { const bf16_t* A; const bf16_t* Bt; int M, N, K, ld; };

struct StaticOrder {
    int nM, nN, nwg, G, c;
    __host__ __device__ void init(int M, int N, int G_, int c_) { nM = M / BM; nN = N / BM; nwg = nM * nN; G = G_; c = c_; }
    __host__ __device__ bool next(int i, Unit& u) const {
        const long L = (long)i * G + c; if (L >= nwg) return false;
        int wgid = (int)L; { const int q = nwg / NXCD, r = nwg % NXCD, xcd = wgid % NXCD, off = wgid / NXCD; wgid = (xcd < r ? xcd * (q + 1) : r * (q + 1) + (xcd - r) * q) + off; }
        const int nig = WGM * nN, gid = wgid / nig, fm = gid * WGM, gsz = (nM - fm) < WGM ? (nM - fm) : WGM;
        u.pm = fm + ((wgid % nig) % gsz); u.pn = (wgid % nig) / gsz; return true;
    }
    __device__ __forceinline__ void a_ready(const Unit&) const {}
    __device__ __forceinline__ void done(const Unit&) const {}
};
typedef float f32x2c_ __attribute__((ext_vector_type(2)));
typedef __bf16 bf16x2c_ __attribute__((ext_vector_type(2)));
__device__ __forceinline__ unsigned cvt_pk_bf16(float lo, float hi) { return __builtin_bit_cast(unsigned, __builtin_convertvector(((f32x2c_){lo, hi}), bf16x2c_)); }
#define EPI_MFMA_SETTLE() do {} while (0)
__device__ __forceinline__ float bf_lo(unsigned w) { return __builtin_bit_cast(float, w << 16); }
__device__ __forceinline__ float bf_hi(unsigned w) { return __builtin_bit_cast(float, w & 0xffff0000u); }
__device__ __forceinline__ float sigmoid_f(float v) { return __builtin_amdgcn_rcpf(1.0f + __expf(-v)); }
__device__ __forceinline__ float silu_f(float v) { return v * sigmoid_f(v); }
template <int ACT> __device__ __forceinline__ float act_f(float v) { if (ACT == 1) return silu_f(v); if (ACT == 2) return sigmoid_f(v); return v; }
__device__ __forceinline__ u32x4 pack8(const f32x4& v0, const f32x4& v1) { u32x4 w; w.x = cvt_pk_bf16(v0[0], v0[1]); w.y = cvt_pk_bf16(v0[2], v0[3]); w.z = cvt_pk_bf16(v1[0], v1[1]); w.w = cvt_pk_bf16(v1[2], v1[3]); return w; }
__device__ __forceinline__ void unpack8(const u32x4 w, f32x4& v0, f32x4& v1) { v0 = (f32x4){bf_lo(w.x), bf_hi(w.x), bf_lo(w.y), bf_hi(w.y)}; v1 = (f32x4){bf_lo(w.z), bf_hi(w.z), bf_lo(w.w), bf_hi(w.w)}; }

struct EpiProj {
    static constexpr bool PERM = true, AFTER_DRAIN = false, KHOOK = false;
    bf16_t *U, *SZ, *MZ, *XBC, *G1, *G2;
    template <int ACT> __device__ __forceinline__ void store_tile(const f32x4 (&acc)[2][2][4][2], bf16_t* base, size_t rs, size_t bs, int row0) const {
#pragma unroll
        for (int ai = 0; ai < 2; ++ai)
#pragma unroll
            for (int m = 0; m < 4; ++m) { bf16_t* rowp = base + (size_t)(row0 + ai * HALF + m * 16) * rs;
#pragma unroll
                for (int bj = 0; bj < 2; ++bj) { f32x4 v0 = acc[ai][bj][m][0], v1 = acc[ai][bj][m][1];
#pragma unroll
                    for (int e = 0; e < 4; ++e) { v0[e] = act_f<ACT>(v0[e]); v1[e] = act_f<ACT>(v1[e]); }
                    __builtin_nontemporal_store(pack8(v0, v1), (u32x4*)(rowp + bj * bs)); } }
    }
    __device__ __forceinline__ void operator()(const f32x4 (&acc)[2][2][4][2], const Unit& u, int wr, int wc, int fr, int fq) const {
        EPI_MFMA_SETTLE();
        const int pn = u.pn, row0 = u.pm * BM + wr * 64 + fr, cl = wc * 32 + 8 * fq;
        if (pn < 16) {
            const int col = pn * BM + cl; store_tile<0>(acc, U + (size_t)(col >> 4) * (8192 * 16) + (col & 15), 16, (size_t)8 * 8192 * 16, row0);
        } else if (pn < 32) {
            store_tile<1>(acc, SZ + (pn - 16) * BM + cl, 4096, HALF, row0);
        } else if (pn < 64) {
            store_tile<1>(acc, MZ + (pn - 32) * BM + cl, 8192, HALF, row0);
        } else if (pn < 104) {
            store_tile<0>(acc, XBC + (pn - 64) * BM + cl, 10240, HALF, row0);
        } else if (pn < 120) {
            store_tile<2>(acc, G1 + (pn - 104) * BM + cl, 4096, HALF, row0);
        } else {
            store_tile<2>(acc, G2 + (pn - 120) * BM + cl, 4096, HALF, row0);
        }
    }
};
struct EpiDTP {
    static constexpr bool PERM = true, AFTER_DRAIN = false, KHOOK = false;
    float* DTP;
    __device__ __forceinline__ void operator()(const f32x4 (&acc)[2][2][4][2], const Unit& u, int wr, int wc, int fr, int fq) const {
        const int row0 = u.pm * BM + wr * 64 + fr, cl = wc * 32 + 8 * fq;
#pragma unroll
        for (int ai = 0; ai < 2; ++ai)
#pragma unroll
            for (int m = 0; m < 4; ++m) { float* rowp = DTP + ((size_t)u.pn * 8192 + row0 + ai * HALF + m * 16) * 128 + cl;
                *(f32x4*)(rowp) = acc[ai][0][m][0]; *(f32x4*)(rowp + 4) = acc[ai][0][m][1]; }
    }
};
struct EpiGlu {
    static constexpr bool PERM = true, AFTER_DRAIN = false, KHOOK = false;
    const bf16_t* SZ; const float* bias; bf16_t* O;
    __device__ __forceinline__ void operator()(const f32x4 (&acc)[2][2][4][2], const Unit& u, int wr, int wc, int fr, int fq) const {
        EPI_MFMA_SETTLE();
        const int row0 = u.pm * BM + wr * 64 + fr, j0 = u.pn * HALF + wc * 32 + 8 * fq;
        const f32x4 ba0 = *(const f32x4*)(bias + j0), ba1 = *(const f32x4*)(bias + j0 + 4), bb0 = *(const f32x4*)(bias + 4096 + j0), bb1 = *(const f32x4*)(bias + 4096 + j0 + 4);
        u32x4 zr[8];
#pragma unroll
        for (int i = 0; i < 8; ++i) zr[i] = *(const u32x4*)(SZ + (size_t)(row0 + (i >> 2) * HALF + (i & 3) * 16) * 4096 + j0);
#pragma unroll
        for (int ai = 0; ai < 2; ++ai)
#pragma unroll
            for (int m = 0; m < 4; ++m) { const size_t off = (size_t)(row0 + ai * HALF + m * 16) * 4096 + j0;
                f32x4 z0, z1; unpack8(zr[ai * 4 + m], z0, z1);
                f32x4 a0 = acc[ai][0][m][0] + ba0, a1 = acc[ai][0][m][1] + ba1, b0 = acc[ai][1][m][0] + bb0, b1 = acc[ai][1][m][1] + bb1;
#pragma unroll
                for (int e = 0; e < 4; ++e) { a0[e] = a0[e] * sigmoid_f(b0[e]) * z0[e]; a1[e] = a1[e] * sigmoid_f(b1[e]) * z1[e]; }
                *(u32x4*)(O + off) = pack8(a0, a1); }
    }
};
struct EpiBrS {
    static constexpr bool PERM = true, AFTER_DRAIN = false, KHOOK = false;
    const bf16_t* G1; bf16_t* T1;
    __device__ __forceinline__ void operator()(const f32x4 (&acc)[2][2][4][2], const Unit& u, int wr, int wc, int fr, int fq) const {
        EPI_MFMA_SETTLE();
        const int row0 = u.pm * BM + wr * 64 + fr, c0 = u.pn * BM + wc * 32 + 8 * fq;
#pragma unroll
        for (int ai = 0; ai < 2; ++ai) { u32x4 gr[8];
#pragma unroll
            for (int i = 0; i < 8; ++i) gr[i] = *(const u32x4*)(G1 + (size_t)(row0 + ai * HALF + (i >> 1) * 16) * 4096 + c0 + (i & 1) * HALF);
#pragma unroll
            for (int m = 0; m < 4; ++m)
#pragma unroll
                for (int bj = 0; bj < 2; ++bj) { const size_t off = (size_t)(row0 + ai * HALF + m * 16) * 4096 + c0 + bj * HALF;
                    f32x4 g0, g1; unpack8(gr[m * 2 + bj], g0, g1);
                    *(u32x4*)(T1 + off) = pack8(acc[ai][bj][m][0] * g0, acc[ai][bj][m][1] * g1); } }
    }
};
struct EpiBrM {
    static constexpr bool PERM = true, AFTER_DRAIN = false, KHOOK = true;
    const bf16_t* G2; const bf16_t* T1; bf16_t* O; const float* RT;
    __device__ __forceinline__ void unit_begin(const Unit& u, PG8_LAS unsigned char* tbl, int tid) const {
        const f32x4 v = *(const f32x4*)(RT + (size_t)u.pm * BM * 8 + 4 * tid); *(PG8_LAS f32x4*)(tbl + 16 * tid) = v;
    }
    __device__ __forceinline__ void khook(f32x4 (&acc)[2][2][4][2], const PG8_LAS unsigned char* tbl, int g, int wr, int fr) const {
#pragma unroll
        for (int ai = 0; ai < 2; ++ai)
#pragma unroll
            for (int m = 0; m < 4; ++m) { const float f = *(const PG8_LAS float*)(tbl + ((ai * HALF + wr * 64 + m * 16 + fr) * 8 + g) * 4);
#pragma unroll
                for (int bj = 0; bj < 2; ++bj)
#pragma unroll
                    for (int n = 0; n < 2; ++n) acc[ai][bj][m][n] = acc[ai][bj][m][n] * f; }
    }
    __device__ __forceinline__ void epi(const f32x4 (&acc)[2][2][4][2], const Unit& u, int wr, int wc, int fr, int fq, const PG8_LAS unsigned char* tbl) const {
        const int row0 = u.pm * BM + wr * 64 + fr, c0 = u.pn * BM + wc * 32 + 8 * fq;
#pragma unroll
        for (int ai = 0; ai < 2; ++ai) { u32x4 gr[8], tr[8];
#pragma unroll
            for (int i = 0; i < 8; ++i) { const size_t off = (size_t)(row0 + ai * HALF + (i >> 1) * 16) * 4096 + c0 + (i & 1) * HALF; gr[i] = *(const u32x4*)(G2 + off); tr[i] = *(const u32x4*)(T1 + off); }
#pragma unroll
            for (int m = 0; m < 4; ++m) { const float f = *(const PG8_LAS float*)(tbl + ((ai * HALF + wr * 64 + m * 16 + fr) * 8 + 7) * 4);
#pragma unroll
                for (int bj = 0; bj < 2; ++bj) { const size_t off = (size_t)(row0 + ai * HALF + m * 16) * 4096 + c0 + bj * HALF;
                    f32x4 g0, g1; unpack8(gr[m * 2 + bj], g0, g1);
                    f32x4 t0, t1; unpack8(tr[m * 2 + bj], t0, t1);
                    *(u32x4*)(O + off) = pack8(t0 + acc[ai][bj][m][0] * (g0 * f), t1 + acc[ai][bj][m][1] * (g1 * f)); } } }
    }
};
struct EpiOut {
    static constexpr bool PERM = true, AFTER_DRAIN = false, KHOOK = false;
    const float* X; const float* gate; bf16_t* O; float* SS;
    __device__ __forceinline__ void operator()(const f32x4 (&acc)[2][2][4][2], const Unit& u, int wr, int wc, int fr, int fq) const {
        EPI_MFMA_SETTLE();
        const int row0 = u.pm * BM + wr * 64 + fr, c0 = u.pn * BM + wc * 32 + 8 * fq;
        f32x4 gv[2][2];
#pragma unroll
        for (int bj = 0; bj < 2; ++bj) { gv[bj][0] = *(const f32x4*)(gate + c0 + bj * HALF); gv[bj][1] = *(const f32x4*)(gate + c0 + bj * HALF + 4); }
#pragma unroll
        for (int ai = 0; ai < 2; ++ai)
#pragma unroll
            for (int mh = 0; mh < 2; ++mh) { f32x4 xr[8];
#pragma unroll
                for (int i = 0; i < 8; ++i) xr[i] = *(const f32x4*)(X + (size_t)(row0 + ai * HALF + (2 * mh + (i >> 2)) * 16) * 4096 + c0 + ((i >> 1) & 1) * HALF + 4 * (i & 1));
#pragma unroll
                for (int mm = 0; mm < 2; ++mm) { const int m = 2 * mh + mm, row = row0 + ai * HALF + m * 16; float s = 0.f;
#pragma unroll
                    for (int bj = 0; bj < 2; ++bj) { const size_t off = (size_t)row * 4096 + c0 + bj * HALF;
                        const f32x4 o0 = xr[mm * 4 + bj * 2] + acc[ai][bj][m][0] * gv[bj][0], o1 = xr[mm * 4 + bj * 2 + 1] + acc[ai][bj][m][1] * gv[bj][1];
                        *(u32x4*)(O + off) = pack8(o0, o1);
                        s += (o0[0] * o0[0] + o0[1] * o0[1]) + (o0[2] * o0[2] + o0[3] * o0[3]) + (o1[0] * o1[0] + o1[1] * o1[1]) + (o1[2] * o1[2] + o1[3] * o1[3]); }
                    s += __shfl_xor(s, 16); s += __shfl_xor(s, 32);
                    if (fq == 0) SS[(size_t)row * 64 + u.pn * 4 + wc] = s; } }
    }
};
template <class Epi, class Sched, bool ALIGN_EPI = false, bool SP2 = false, bool SPLITK = false>
__device__ __forceinline__ void gemm_phase(PG8_LAS unsigned char* lds, const Gemm g, const Sched& S, const Epi& E) {
    const int tid = threadIdx.x, wid = __builtin_amdgcn_readfirstlane(tid >> 6), lane = tid & 63, wr = wid >> 2, wc = wid & 3, fr = lane & 15, fq = lane >> 4;
    const int K = g.K, nt = K / BK, LD = g.ld;
    unsigned voffA[2], voffB[2];
#pragma unroll
    for (int i = 0; i < 2; ++i) { int R, C; stage_rc(tid * 16 + i * 8192, R, C); const int Rb = Epi::PERM ? ((R & ~31) + perm32(R & 31)) : R;
        voffA[i] = (unsigned)(R * LD + C) * 2u; voffB[i] = (unsigned)(Rb * LD + C) * 2u; }
    const size_t kstep = (size_t)(BK * 2);
    const size_t hstep = (size_t)HALF * LD * 2;
    const size_t tstep = 2 * hstep;
    const unsigned ldsw = (unsigned)wid * 1024u;
    const int aoff = lds_byte(wr * 64 + fr, fq * 8), boff = lds_byte(wc * 32 + fr, fq * 8);
#define PG8_SA(b, h) (((b) * 2 + (h)) * HTB)
#define PG8_SB(b, h) ((4 + (b) * 2 + (h)) * HTB)
#define PG8_STAGE(bufoff, gbase, voff) do { _Pragma("unroll") for (int _i = 0; _i < 2; ++_i) \
        __builtin_amdgcn_global_load_lds((const unsigned*)((const char*)(gbase) + (voff)[_i]), (PG8_LAS unsigned*)(lds + (bufoff) + ldsw + _i * 8192), 16, 0, 0); } while (0)
#define PG8_LDA(dst, b, h) do { _Pragma("unroll") for (int m = 0; m < 4; ++m) _Pragma("unroll") for (int k = 0; k < 2; ++k) dst[m][k] = *(const PG8_LAS bf16x8*)(lds + PG8_SA(b, h) + aoff + m * 2048 + k * 1024); } while (0)
#define PG8_LDB(dst, b, h) do { _Pragma("unroll") for (int n = 0; n < 2; ++n) _Pragma("unroll") for (int k = 0; k < 2; ++k) dst[n][k] = *(const PG8_LAS bf16x8*)(lds + PG8_SB(b, h) + boff + n * 2048 + k * 1024); } while (0)
#define PG8_MMA(ai, bj, At, Bt) do { __builtin_amdgcn_s_setprio(1); _Pragma("unroll") for (int m = 0; m < 4; ++m) _Pragma("unroll") for (int n = 0; n < 2; ++n) _Pragma("unroll") for (int k = 0; k < 2; ++k) \
        acc[ai][bj][m][n] = __builtin_amdgcn_mfma_f32_16x16x32_bf16(Bt[n][k], At[m][k], acc[ai][bj][m][n], 0, 0, 0); __builtin_amdgcn_s_setprio(0); } while (0)
#define PG8_WAIT_V(n) asm volatile("s_waitcnt vmcnt(" #n ")" ::: "memory")
#define PG8_WAIT_L(n) asm volatile("s_waitcnt lgkmcnt(" #n ")" ::: "memory")
#define PG8_BAR __builtin_amdgcn_s_barrier()
#define PG8_SCHED __builtin_amdgcn_sched_barrier(0)
    Unit cur, nxt; int ui = 0;
    if (!S.next(0, cur)) return;
    f32x4 acc[2][2][4][2];
#pragma unroll
    for (int a = 0; a < 2; ++a)
#pragma unroll
        for (int b = 0; b < 2; ++b)
#pragma unroll
            for (int m = 0; m < 4; ++m)
#pragma unroll
                for (int n = 0; n < 2; ++n) acc[a][b][m][n] = (f32x4){0.f, 0.f, 0.f, 0.f};
    bf16x8 At[4][2], B0[2][2], B1[2][2];
    const char* cA = (const char*)g.A + (size_t)cur.pm * tstep + (SPLITK ? (size_t)cur.pn * K * 2 : (size_t)0); const char* cB = (const char*)g.Bt + (SPLITK ? (size_t)cur.pn * K * 2 : (size_t)cur.pn * tstep);
    S.a_ready(cur);
    if constexpr (SP2) {
        PG8_STAGE(PG8_SB(0, 0), cB, voffB); PG8_STAGE(PG8_SB(0, 1), cB + hstep, voffB); PG8_STAGE(PG8_SA(0, 0), cA, voffA); PG8_STAGE(PG8_SA(0, 1), cA + hstep, voffA);
        if (wr == 1) PG8_BAR;
        PG8_WAIT_V(2); PG8_BAR;
        PG8_STAGE(PG8_SB(1, 0), cB + kstep, voffB); PG8_STAGE(PG8_SA(1, 0), cA + kstep, voffA); PG8_STAGE(PG8_SB(1, 1), cB + hstep + kstep, voffB);
        PG8_WAIT_V(6); PG8_BAR;
    } else {
        PG8_STAGE(PG8_SB(0, 0), cB, voffB); PG8_STAGE(PG8_SA(0, 0), cA, voffA); PG8_STAGE(PG8_SB(0, 1), cB + hstep, voffB); PG8_STAGE(PG8_SA(0, 1), cA + hstep, voffA);
        if (wr == 1) PG8_BAR;
        PG8_WAIT_V(4); PG8_BAR;
        PG8_STAGE(PG8_SB(1, 0), cB + kstep, voffB); PG8_STAGE(PG8_SA(1, 0), cA + kstep, voffA); PG8_STAGE(PG8_SB(1, 1), cB + hstep + kstep, voffB);
        PG8_WAIT_V(6); PG8_BAR;
    }
    for (;;) {
        const bool has_next = S.next(ui + 1, nxt);
        if constexpr (Epi::KHOOK) E.unit_begin(cur, lds + STAGE_BYTES + (ui & 1) * 8192, tid);
        const char* nA = has_next ? (const char*)g.A + (size_t)nxt.pm * tstep + (SPLITK ? (size_t)nxt.pn * K * 2 : (size_t)0) : cA; const char* nB = has_next ? (const char*)g.Bt + (SPLITK ? (size_t)nxt.pn * K * 2 : (size_t)nxt.pn * tstep) : cB;
        for (int t = 0; t < nt; t += 2) {
            const bool last = (t == nt - 2);
            const char* a1 = cA + (size_t)(t + 1) * kstep;
            const char* a2 = last ? nA : cA + (size_t)(t + 2) * kstep; const char* b2 = last ? nB : cB + (size_t)(t + 2) * kstep;
            const char* a3 = a2 + kstep; const char* b3 = b2 + kstep;
            if (last && has_next) S.a_ready(nxt);
            if constexpr (SP2) {
            PG8_LDB(B0, 0, 0); PG8_LDB(B1, 0, 1); PG8_SCHED; PG8_LDA(At, 0, 0); PG8_STAGE(PG8_SA(1, 1), a1 + hstep, voffA);
            PG8_WAIT_V(8); PG8_WAIT_L(0); PG8_BAR; PG8_MMA(0, 0, At, B0); PG8_MMA(0, 1, At, B1); PG8_BAR; PG8_SCHED;
            PG8_LDA(At, 0, 1); PG8_STAGE(PG8_SB(0, 0), b2, voffB); PG8_STAGE(PG8_SB(0, 1), b2 + hstep, voffB); PG8_STAGE(PG8_SA(0, 0), a2, voffA);
            PG8_WAIT_V(8); PG8_WAIT_L(0); PG8_BAR; PG8_MMA(1, 0, At, B0); PG8_MMA(1, 1, At, B1); PG8_BAR; PG8_SCHED;
            PG8_LDB(B0, 1, 0); PG8_LDB(B1, 1, 1); PG8_SCHED; PG8_LDA(At, 1, 0); PG8_STAGE(PG8_SA(0, 1), a2 + hstep, voffA);
            PG8_WAIT_V(8); PG8_WAIT_L(0); PG8_BAR; PG8_MMA(0, 0, At, B0); PG8_MMA(0, 1, At, B1); PG8_BAR; PG8_SCHED;
            PG8_LDA(At, 1, 1); PG8_STAGE(PG8_SB(1, 0), b3, voffB); PG8_STAGE(PG8_SB(1, 1), b3 + hstep, voffB); PG8_STAGE(PG8_SA(1, 0), a3, voffA);
            PG8_WAIT_V(8); PG8_WAIT_L(0); PG8_BAR; PG8_MMA(1, 0, At, B0); PG8_MMA(1, 1, At, B1); PG8_BAR; PG8_SCHED;
            if constexpr (Epi::KHOOK) { if ((t & 15) == 14 && !last) { E.khook(acc, lds + STAGE_BYTES + (ui & 1) * 8192, t >> 4, wr, fr); } }
            } else {
            PG8_LDB(B0, 0, 0); PG8_SCHED; PG8_LDA(At, 0, 0); PG8_STAGE(PG8_SA(1, 1), a1 + hstep, voffA);
            PG8_WAIT_L(8); PG8_BAR; PG8_WAIT_L(0); PG8_MMA(0, 0, At, B0); PG8_BAR; PG8_SCHED;
            PG8_LDB(B1, 0, 1); PG8_STAGE(PG8_SB(0, 0), b2, voffB);
            PG8_BAR; PG8_WAIT_L(0); PG8_MMA(0, 1, At, B1); PG8_BAR;
            PG8_LDA(At, 0, 1); PG8_STAGE(PG8_SA(0, 0), a2, voffA);
            PG8_BAR; PG8_WAIT_L(0); PG8_MMA(1, 0, At, B0); PG8_BAR; PG8_SCHED;
            PG8_STAGE(PG8_SB(0, 1), b2 + hstep, voffB);
            PG8_WAIT_V(6); PG8_BAR; PG8_MMA(1, 1, At, B1); PG8_BAR;
            PG8_LDB(B0, 1, 0); PG8_SCHED; PG8_LDA(At, 1, 0); PG8_STAGE(PG8_SA(0, 1), a2 + hstep, voffA);
            PG8_WAIT_L(8); PG8_BAR; PG8_WAIT_L(0); PG8_MMA(0, 0, At, B0); PG8_BAR; PG8_SCHED;
            PG8_LDB(B1, 1, 1); PG8_STAGE(PG8_SB(1, 0), b3, voffB);
            PG8_BAR; PG8_WAIT_L(0); PG8_MMA(0, 1, At, B1); PG8_BAR;
            PG8_LDA(At, 1, 1); PG8_STAGE(PG8_SA(1, 0), a3, voffA);
            PG8_BAR; PG8_WAIT_L(0); PG8_MMA(1, 0, At, B0); PG8_BAR; PG8_SCHED;
            PG8_STAGE(PG8_SB(1, 1), b3 + hstep, voffB);
            PG8_WAIT_V(6); PG8_BAR; PG8_MMA(1, 1, At, B1); PG8_BAR;
            }
        }
        if constexpr (ALIGN_EPI) { if (wr == 0) PG8_BAR; }
        if constexpr (!Epi::AFTER_DRAIN) { if constexpr (Epi::KHOOK) E.epi(acc, cur, wr, wc, fr, fq, lds + STAGE_BYTES + (ui & 1) * 8192); else E(acc, cur, wr, wc, fr, fq); S.done(cur); }
        if (!has_next) break;
#pragma unroll
        for (int a = 0; a < 2; ++a)
#pragma unroll
            for (int b = 0; b < 2; ++b)
#pragma unroll
                for (int m = 0; m < 4; ++m)
#pragma unroll
                    for (int n = 0; n < 2; ++n) acc[a][b][m][n] = (f32x4){0.f, 0.f, 0.f, 0.f};
        cur = nxt; cA = nA; cB = nB; ++ui;
        if constexpr (ALIGN_EPI) { if (wr == 1) PG8_BAR; }
    }
    PG8_WAIT_V(0);
    if constexpr (!ALIGN_EPI) { if (wr == 0) PG8_BAR; }
    PG8_BAR;
    if constexpr (Epi::AFTER_DRAIN) { E.fused(acc, cur, wr, wc, fr, fq, lds, wid, lane); S.done(cur); }
#undef PG8_SA
#undef PG8_SB
#undef PG8_STAGE
#undef PG8_LDA
#undef PG8_LDB
#undef PG8_MMA
#undef PG8_WAIT_V
#undef PG8_WAIT_L
#undef PG8_BAR
#undef PG8_SCHED
}
}
#ifndef PG8_SP2
#define PG8_SP2 true
#endif
#ifndef PG8_ALIGN
#define PG8_ALIGN true
#endif
constexpr int NWAVES = 8;
#ifndef MK_N_LAUNCHES
#define MK_N_LAUNCHES 1
#endif
constexpr int NPH = 11;
constexpr int N_LAUNCHES = MK_N_LAUNCHES;

constexpr int M = 8192, D = 4096;
constexpr int S5G = 256, S5P = 16, S5N = 64;
constexpr int DI = 8192, NH = 128, HD = 64, NG = 8, NS = 128, CONVD = 10240;
constexpr int IN_COLS = 34944, NPROJ = 35072, NMAIN = 34816;
constexpr float EPS = 1e-6f;

constexpr size_t MiB = 1u << 20;
constexpr size_t WS_CTL = 0, CTL_ZERO_BYTES = 1 * MiB;
constexpr size_t WS_MODP = 1 * MiB;
constexpr size_t WS_GATE = 1 * MiB + 512 * 1024;
constexpr size_t WS_SS = 2 * MiB;
constexpr size_t WS_S5C = 2 * MiB;
constexpr size_t WS_DT = 4 * MiB;
constexpr size_t WS_WGLU = 8 * MiB, WS_WBRS = 72 * MiB, WS_WBRM = 104 * MiB, WS_WOUT = 168 * MiB;
constexpr size_t WS_U = 200 * MiB;
constexpr size_t WS_SZ = 264 * MiB;
constexpr size_t WS_MZ = 328 * MiB;
constexpr size_t WS_XBC = 456 * MiB;
constexpr size_t WS_G1 = 616 * MiB, WS_G2 = 680 * MiB;
constexpr size_t WS_WIN = 744 * MiB;
constexpr size_t WS_YSSD = 744 * MiB, WS_YM2 = 872 * MiB;
constexpr size_t WS_H = 1018 * MiB;
constexpr size_t WS_YS5 = 1018 * MiB;
constexpr size_t WS_XC = 1082 * MiB;
constexpr size_t WS_DTS = 1242 * MiB;
constexpr size_t WS_END = 1246 * MiB;
constexpr size_t WS_YS5G = WS_U, WS_MERGED = WS_SZ, WS_T1 = WS_MZ;
constexpr size_t WS_X2 = WS_G1;
static_assert(WS_WIN + (size_t)NPROJ * D * 2 <= WS_H && WS_H + (size_t)M * D * 2 <= WS_XC && WS_XC + (size_t)M * CONVD * 2 <= WS_DTS, "d_ws map");
constexpr int CW_BAR = 4096;

constexpr int RING_OFF = 0, RING_BYTES = 131072;
constexpr int LDSCTL_OFF = 151552, MISC_OFF = LDSCTL_OFF + 320;
constexpr int LDS_BYTES = 155648;
static_assert(MISC_OFF + 128 <= LDS_BYTES, "LDS map");

#define GAS __attribute__((address_space(1)))
#define LAS __attribute__((address_space(3)))
typedef unsigned short bf16;
typedef unsigned v4u __attribute__((ext_vector_type(4)));
typedef unsigned v2u __attribute__((ext_vector_type(2)));
typedef float f32x4 __attribute__((ext_vector_type(4)));
typedef short bf16x8 __attribute__((ext_vector_type(8)));
typedef GAS unsigned gu32;
#define RLX_AGENT __ATOMIC_RELAXED, __HIP_MEMORY_SCOPE_AGENT
#define LDS_WAIT() asm volatile("s_waitcnt lgkmcnt(0)" ::: "memory")
#define VM_WAIT() asm volatile("s_waitcnt vmcnt(0)" ::: "memory")
typedef float f32x2c __attribute__((ext_vector_type(2)));
typedef __bf16 bf16x2c __attribute__((ext_vector_type(2)));
__device__ __forceinline__ unsigned pk2(float lo, float hi) { return __builtin_bit_cast(unsigned, __builtin_convertvector(((f32x2c){lo, hi}), bf16x2c)); }
__device__ __forceinline__ unsigned f2bf(float f) { return pk2(f, 0.f) & 0xffffu; }
__device__ __forceinline__ float bf2f(bf16 h) { return __builtin_bit_cast(float, (unsigned)h << 16); }
using pg8::bf_lo; using pg8::bf_hi;
#define XB_TMO      128
#define XB_XCNT(j)  (256  + 64 * (j))
#define XB_XSUB(j)  (1280 + 64 * (j))
#define XB_XGEN(j)  (2304 + 64 * (j))
#define XB_TOP      3328
#define XB_TOPGEN   3392
#define XCD_BAR_WORDS 3456
#define XB_SPIN_CAP (1u << 18)

__device__ __forceinline__ unsigned xb_ld(unsigned* p)              { return __hip_atomic_load(p, __ATOMIC_RELAXED, __HIP_MEMORY_SCOPE_AGENT); }
__device__ __forceinline__ unsigned xb_add(unsigned* p, unsigned v) { return __hip_atomic_fetch_add(p, v, __ATOMIC_RELAXED, __HIP_MEMORY_SCOPE_AGENT); }
__device__ __forceinline__ unsigned xb_xcc_id() { return (unsigned)__builtin_amdgcn_s_getreg((3 << 11) | 20) & 0xFu; }
#define XB_SPIN(cond, bar) do { unsigned _sp = 0; while (cond) { __builtin_amdgcn_s_sleep(1); \
    if ((++_sp & 255u) == 0u) { if (xb_ld(&(bar)[XB_TMO])) break; if (_sp > XB_SPIN_CAP) { atomicAdd(&(bar)[XB_TMO], 1u); break; } } } } while (0)

struct XcdBarrier {
    unsigned* bar; unsigned x;
    volatile LAS unsigned* st;
};

__device__ __forceinline__ XcdBarrier xcd_barrier_post(unsigned* bar, volatile LAS unsigned* st) {
    XcdBarrier b; b.bar = bar; b.x = xb_xcc_id(); b.st = st;
    if (threadIdx.x == 0) (void)xb_add(&bar[XB_XCNT(b.x)], 1u);
    return b;
}
__device__ __forceinline__ void xcd_barrier_complete(unsigned* bar, unsigned x, unsigned& nloc, unsigned& nx) {
    const unsigned G = gridDim.x * gridDim.y * gridDim.z;
    unsigned sum, cnt, mine, sp = 0u;
    for (;;) {
        sum = 0u; cnt = 0u; mine = 0u;
#pragma unroll
        for (unsigned j = 0; j < 16; ++j) { const unsigned c = xb_ld(&bar[XB_XCNT(j)]); sum += c; cnt += (c > 0u) ? 1u : 0u; mine = (j == x) ? c : mine; }
        if (sum == G) break;
        __builtin_amdgcn_s_sleep(1);
        if ((++sp & 255u) == 0u) { if (xb_ld(&bar[XB_TMO])) break; if (sp > XB_SPIN_CAP) { atomicAdd(&bar[XB_TMO], 1u); break; } }
    }
    nloc = mine > 0u ? mine : 1u; nx = cnt > 0u ? cnt : 1u;
}

__device__ __forceinline__ void xcd_barrier(const XcdBarrier& b) {
    asm volatile("s_waitcnt vmcnt(0)" ::: "memory");
    __syncthreads();
    if (threadIdx.x == 0) {
        unsigned* bar = b.bar;
        __builtin_amdgcn_s_waitcnt(0);
        unsigned nloc = b.st[0], nx = b.st[1];
        if (nloc == 0u) { xcd_barrier_complete(bar, b.x, nloc, nx); b.st[0] = nloc; b.st[1] = nx; }
        const unsigned old = xb_add(&bar[XB_XSUB(b.x)], 1u);
        const unsigned gen = old / nloc;
        if (old + 1u == (gen + 1u) * nloc) {
            __builtin_amdgcn_fence(__ATOMIC_RELEASE, "agent");
            asm volatile("s_waitcnt vmcnt(0)" ::: "memory");
            const unsigned og = xb_add(&bar[XB_TOP], 1u);
            const unsigned tg = og / nx;
            if (og + 1u == (tg + 1u) * nx) xb_add(&bar[XB_TOPGEN], 1u);
            else XB_SPIN(xb_ld(&bar[XB_TOPGEN]) == tg, bar);
            __builtin_amdgcn_fence(__ATOMIC_ACQUIRE, "agent");
            xb_add(&bar[XB_XGEN(b.x)], 1u);
            asm volatile("s_waitcnt vmcnt(0)" ::: "memory");
        } else {
            XB_SPIN(xb_ld(&bar[XB_XGEN(b.x)]) == gen, bar);
            __builtin_amdgcn_fence(__ATOMIC_ACQUIRE, "agent");
            asm volatile("s_waitcnt vmcnt(0)" ::: "memory");
        }
    }
    __syncthreads();
}
__device__ __forceinline__ float wave_sum(float v) {
#pragma unroll
    for (int o = 1; o < 64; o <<= 1) v += __shfl_xor(v, o);
    return v;
}
constexpr int TR_PITCH = 34, TR_BYTES = 64 * TR_PITCH * 2;
__device__ __forceinline__ void p0_transpose_item(const float* W, int K, int N, bf16* WT, int src_n0, int dst_n0, int k0, LAS bf16* scr, int lane, const float* kscale = nullptr) {
    if (src_n0 >= 0) {
        f32x4 v[8];
#pragma unroll
        for (int i = 0; i < 8; ++i) v[i] = __builtin_nontemporal_load((const GAS f32x4*)(W + (size_t)(k0 + 8 * i + (lane >> 3)) * N + src_n0 + 4 * (lane & 7)));
        if (kscale) {
#pragma unroll
            for (int i = 0; i < 8; ++i) v[i] = v[i] * kscale[k0 + 8 * i + (lane >> 3)]; }
#pragma unroll
        for (int i = 0; i < 8; ++i) { LAS unsigned* d = (LAS unsigned*)(scr + (8 * i + (lane >> 3)) * TR_PITCH + 4 * (lane & 7)); d[0] = pk2(v[i].x, v[i].y); d[1] = pk2(v[i].z, v[i].w); }
    } else {
#pragma unroll
        for (int i = 0; i < 8; ++i) { LAS unsigned* d = (LAS unsigned*)(scr + (8 * i + (lane >> 3)) * TR_PITCH + 4 * (lane & 7)); d[0] = 0u; d[1] = 0u; }
    }
    LDS_WAIT(); asm volatile("" ::: "memory");
    const int c = lane & 7;
#pragma unroll
    for (int j = 0; j < 4; ++j) { const int n = (lane >> 3) + 8 * j; const LAS bf16* s = scr + (8 * c) * TR_PITCH + n;
        v4u o; o.x = (unsigned)s[0] | ((unsigned)s[TR_PITCH] << 16); o.y = (unsigned)s[2 * TR_PITCH] | ((unsigned)s[3 * TR_PITCH] << 16);
        o.z = (unsigned)s[4 * TR_PITCH] | ((unsigned)s[5 * TR_PITCH] << 16); o.w = (unsigned)s[6 * TR_PITCH] | ((unsigned)s[7 * TR_PITCH] << 16);
        *(GAS v4u*)(WT + (size_t)(dst_n0 + n) * K + k0 + 8 * c) = o; }
    LDS_WAIT(); asm volatile("" ::: "memory");
}
__device__ __forceinline__ int win_src_col(int d) { return d < 26624 ? d : (d < 34816 ? d + 128 : (d < 34944 ? d - 34816 + 26624 : -1)); }
__device__ __forceinline__ int wglu_src_col(int d) { const int pn = d >> 8, r = d & 255; return r < 128 ? 128 * pn + r : 4096 + 128 * pn + (r - 128); }

struct Args {
    const float *x, *c, *w_ada, *b_ada, *norm_g, *w_in, *lam_re, *lam_im, *log_step, *b_re, *b_im, *c_re, *c_im, *s5_d, *w_glu, *b_glu,
                *conv_w, *conv_b, *dt_bias, *a_log, *m2_d, *m2_norm_g, *w_br_s5, *w_br_m2, *w_out, *final_g;
    float* out; unsigned char* ws; int ph_lo, ph_hi, sub, pad;
};

__device__ __forceinline__ void p0_gemv(const float* c, const float* W, float* MODP, LAS float* red, int wg, int G, int tid) {
    const int cg = tid & 31, rg = tid >> 5;
    for (int it = wg; it < 768; it += G) {
        const int cb = it % 96, ks = it / 96;
        const float* wp = W + (size_t)(ks * 512 + rg) * 12288 + cb * 128 + cg * 4;
        const float* cp = c + ks * 512 + rg;
        f32x4 acc = (f32x4){0.f, 0.f, 0.f, 0.f};
#pragma unroll 8
        for (int i = 0; i < 32; ++i) { const f32x4 w = __builtin_nontemporal_load((const f32x4*)(wp + (size_t)i * 16 * 12288)); const float cv = cp[i * 16]; acc = acc + w * cv; }
        *(LAS f32x4*)(red + rg * 128 + cg * 4) = acc;
        __syncthreads();
        if (tid < 128) { float s = 0.f;
#pragma unroll
            for (int r = 0; r < 16; ++r) s += red[r * 128 + tid];
            MODP[ks * 12288 + cb * 128 + tid] = s; }
        __syncthreads();
    }
}
__device__ __forceinline__ void p0_weights_in(const Args& a, LAS bf16* scr, int gw, int NGW, int lane) {
    bf16* WIN = (bf16*)(a.ws + WS_WIN);
    constexpr int I_IN = (D / 64) * (NPROJ / 32);
    for (int r = gw; r < I_IN; r += NGW) { const int nblk = NPROJ / 32, kb = r / nblk, nb = r % nblk; p0_transpose_item(a.w_in, D, IN_COLS, WIN, win_src_col(32 * nb), 32 * nb, 64 * kb, scr, lane); }
}
constexpr int P3_NCONV = 16 * 512, P3_NWITEMS = (D / 64) * (8192 / 32) + 2 * (D / 64) * (D / 32) + (DI / 64) * (D / 32);
__device__ __forceinline__ void p3_weight_item(const Args& a, LAS bf16* scr, int it, int lane) {
    bf16* WGLU = (bf16*)(a.ws + WS_WGLU); bf16* WBRS = (bf16*)(a.ws + WS_WBRS); bf16* WBRM = (bf16*)(a.ws + WS_WBRM); bf16* WOUT = (bf16*)(a.ws + WS_WOUT);
    constexpr int I_GLU = (D / 64) * (8192 / 32), I_BRS = (D / 64) * (D / 32), I_BRM = (DI / 64) * (D / 32), I_OUT = (D / 64) * (D / 32);
    static_assert(I_GLU + I_BRS + I_BRM + I_OUT == P3_NWITEMS, "item count");
    int r = it;
    if (r < I_GLU) { const int nblk = 8192 / 32, kb = r / nblk, nb = r % nblk; p0_transpose_item(a.w_glu, D, 8192, WGLU, wglu_src_col(32 * nb), 32 * nb, 64 * kb, scr, lane); return; } r -= I_GLU;
    if (r < I_BRS) { const int nblk = D / 32, kb = r / nblk, nb = r % nblk; p0_transpose_item(a.w_br_s5, D, D, WBRS, 32 * nb, 32 * nb, 64 * kb, scr, lane); return; } r -= I_BRS;
    if (r < I_BRM) { const int nblk = D / 32, kb = r / nblk, nb = r % nblk; p0_transpose_item(a.w_br_m2, DI, D, WBRM, 32 * nb, 32 * nb, 64 * kb, scr, lane, a.m2_norm_g); return; } r -= I_BRM;
    { const int nblk = D / 32, kb = r / nblk, nb = r % nblk; p0_transpose_item(a.w_out, D, D, WOUT, 32 * nb, 32 * nb, 64 * kb, scr, lane); }
}
__device__ __forceinline__ void p1_h(const Args& a, LAS float* ldsA, LAS float* ldsB, int gw, int NGW, int tid, int lane) {
    const float* MODP = (const float*)(a.ws + WS_MODP); float* GATE = (float*)(a.ws + WS_GATE); bf16* H = (bf16*)(a.ws + WS_H);
    for (int j = tid; j < 12288; j += NWAVES * 64) { float s = a.b_ada[j];
#pragma unroll
        for (int ks = 0; ks < 8; ++ks) s += MODP[ks * 12288 + j];
        if (j < 4096) ldsB[j] = s; else if (j < 8192) ldsA[j - 4096] = a.norm_g[j - 4096] * (1.0f + s); else if (blockIdx.x == 0) GATE[j - 8192] = s; }
    __syncthreads();
    for (int row = gw; row < M; row += NGW) {
        const GAS f32x4* xr = (const GAS f32x4*)(a.x + (size_t)row * D);
        f32x4 v[16]; float ss = 0.f;
#pragma unroll
        for (int j = 0; j < 8; ++j) { v[2 * j] = __builtin_nontemporal_load(xr + 128 * j + 2 * lane); v[2 * j + 1] = __builtin_nontemporal_load(xr + 128 * j + 2 * lane + 1); }
#pragma unroll
        for (int j = 0; j < 16; ++j) ss += (v[j].x * v[j].x + v[j].y * v[j].y) + (v[j].z * v[j].z + v[j].w * v[j].w);
        const float rstd = 1.0f / sqrtf(wave_sum(ss) * (1.0f / D) + EPS);
#pragma unroll
        for (int j = 0; j < 8; ++j) { const int col = 512 * j + 8 * lane;
            const f32x4 a0 = *(const LAS f32x4*)(ldsA + col), a1 = *(const LAS f32x4*)(ldsA + col + 4), b0 = *(const LAS f32x4*)(ldsB + col), b1 = *(const LAS f32x4*)(ldsB + col + 4);
            const f32x4 h0 = v[2 * j] * rstd * a0 + b0, h1 = v[2 * j + 1] * rstd * a1 + b1;
            v4u o; o.x = pk2(h0.x, h0.y); o.y = pk2(h0.z, h0.w); o.z = pk2(h1.x, h1.y); o.w = pk2(h1.z, h1.w);
            *(GAS v4u*)(H + (size_t)row * D + col) = o; }
    }
}
__device__ __forceinline__ float gelu_tanh(float x) { const float z = 0.7978845608028654f * (x + 0.044715f * x * x * x); return x * __builtin_amdgcn_rcpf(1.0f + __expf(-2.0f * z)); }
__device__ __forceinline__ float softplus_f(float x) { return fmaxf(x, 0.f) + log1pf(expf(-fabsf(x))); }
__device__ __forceinline__ void conv_task(const Args& a, int task, int lane) {
    const bf16* XBC = (const bf16*)(a.ws + WS_XBC); bf16* XC = (bf16*)(a.ws + WS_XC);
    {
        const int cb = task & 15, t0 = (task >> 4) * 16;
        const int c8 = (cb * 64 + lane) * 8;
        f32x4 w0[4], w1[4];
#pragma unroll
        for (int k = 0; k < 4; ++k) { w0[k] = *(const f32x4*)(a.conv_w + k * CONVD + c8); w1[k] = *(const f32x4*)(a.conv_w + k * CONVD + c8 + 4); }
        const f32x4 b0 = *(const f32x4*)(a.conv_b + c8), b1 = *(const f32x4*)(a.conv_b + c8 + 4);
        v4u raw[19];
#pragma unroll
        for (int i = 0; i < 19; ++i) { const int tt = t0 - 3 + i; raw[i] = (v4u){0u, 0u, 0u, 0u}; if (tt >= 0) raw[i] = __builtin_nontemporal_load((const GAS v4u*)(XBC + (size_t)tt * CONVD + c8)); }
        f32x4 r0[4], r1[4];
#pragma unroll
        for (int i = 0; i < 3; ++i) pg8::unpack8(raw[i], r0[i], r1[i]);
#pragma unroll
        for (int i = 3; i < 19; ++i) { pg8::unpack8(raw[i], r0[i & 3], r1[i & 3]);
            f32x4 acc0 = b0, acc1 = b1;
#pragma unroll
            for (int k = 0; k < 4; ++k) { acc0 = acc0 + r0[(i - 3 + k) & 3] * w0[k]; acc1 = acc1 + r1[(i - 3 + k) & 3] * w1[k]; }
#pragma unroll
            for (int e = 0; e < 4; ++e) { acc0[e] = pg8::silu_f(acc0[e]); acc1[e] = pg8::silu_f(acc1[e]); }
            v4u o; o.x = pk2(acc0.x, acc0.y); o.y = pk2(acc0.z, acc0.w); o.z = pk2(acc1.x, acc1.y); o.w = pk2(acc1.z, acc1.w);
            *(GAS v4u*)(XC + (size_t)(t0 + i - 3) * CONVD + c8) = o; }
    }
}
__device__ __forceinline__ void final_norm(const Args& a, int gw, int NGW, int lane) {
    const float* SS = (const float*)(a.ws + WS_SS); const bf16* X2 = (const bf16*)(a.ws + WS_X2);
    for (int row = gw; row < M; row += NGW) {
        const GAS v4u* xr = (const GAS v4u*)(X2 + (size_t)row * D); GAS f32x4* orow = (GAS f32x4*)(a.out + (size_t)row * D);
        v4u r[8];
#pragma unroll
        for (int j = 0; j < 8; ++j) r[j] = xr[64 * j + lane];
        const float rstd = 1.0f / sqrtf(wave_sum(SS[(size_t)row * 64 + lane]) * (1.0f / D) + EPS);
#pragma unroll
        for (int j = 0; j < 8; ++j) { const int col = 512 * j + 8 * lane; f32x4 v0, v1; pg8::unpack8(r[j], v0, v1);
            orow[128 * j + 2 * lane] = v0 * rstd * *(const f32x4*)(a.final_g + col); orow[128 * j + 2 * lane + 1] = v1 * rstd * *(const f32x4*)(a.final_g + col + 4); }
    }
}
constexpr int P3_CNT_OFF = 139264;
__device__ __forceinline__ void p3_stream_items(const Args& a, LAS unsigned char* L, LAS bf16* scr, int vcu, int G, int lane) {
    LAS unsigned* cnt = (LAS unsigned*)(L + P3_CNT_OFF);
    for (;;) {
        unsigned idx = 0u; if (lane == 0) idx = __hip_atomic_fetch_add(cnt, 1u, __ATOMIC_RELAXED, __HIP_MEMORY_SCOPE_WORKGROUP);
        idx = (unsigned)__builtin_amdgcn_readfirstlane((int)idx);
        const long id = (long)idx * G + vcu;
        if (id < P3_NCONV) conv_task(a, (int)id, lane);
        else if (id < P3_NCONV + P3_NWITEMS) p3_weight_item(a, scr, (int)(id - P3_NCONV), lane);
        else break;
    }
}
__device__ __forceinline__ void s5_consts(const Args& a, size_t gt, size_t NT) {
    float* S5C = (float*)(a.ws + WS_S5C);
    for (size_t idx = gt; idx < (size_t)S5G * S5N; idx += NT) {
        const int g = (int)(idx >> 6);
        const double step = exp((double)a.log_step[g]);
        const double lre = (double)a.lam_re[idx], lim = (double)a.lam_im[idx];
        const double mag = exp(lre * step), ang = lim * step;
        const double lbr_d = mag * cos(ang), lbi_d = mag * sin(ang);
        const double den = lre * lre + lim * lim, nr = lbr_d - 1.0, ni = lbi_d;
        const double cr = (nr * lre + ni * lim) / den, ci = (ni * lre - nr * lim) / den;
        const float lbr = (float)lbr_d, lbi = (float)lbi_d;
        double pr = (double)lbr, pi = (double)lbi;
#pragma unroll 1
        for (int i = 0; i < 11; ++i) { const double r2 = pr * pr - pi * pi, i2 = 2.0 * pr * pi; pr = r2; pi = i2; }
        *(f32x4*)(S5C + idx * 8) = (f32x4){lbr, lbi, (float)cr, (float)ci}; *(f32x4*)(S5C + idx * 8 + 4) = (f32x4){(float)pr, (float)pi, 0.f, 0.f};
    }
}
constexpr int S5W = 4, S5_SEG = M / S5W, S5_NCH = S5_SEG / 128, S5_NNB = S5_SEG / 256, S5_TQ = 8 / S5W;
constexpr int S5_APP = 264;
constexpr int S5_WLDS = 16896, S5_BU = 0, S5_SB = 8448, S5_US = 12800, S5_E = 8 * S5_WLDS;
typedef float f32x2v __attribute__((ext_vector_type(2)));
#define MFMA16(a, b, c) __builtin_amdgcn_mfma_f32_16x16x32_bf16((a), (b), (c), 0, 0, 0)
__device__ __forceinline__ void s5_bu_to_lds(const bf16x8 (&Af)[8], const bf16x8 Bf, LAS float* Bu, int lane) {
#pragma unroll
    for (int mb = 0; mb < 8; ++mb) { const f32x4 d = MFMA16(Af[mb], Bf, ((f32x4){0.f, 0.f, 0.f, 0.f})); *(LAS f32x4*)(Bu + (lane & 15) * 132 + 16 * mb + 4 * (lane >> 4)) = d; }
    LDS_WAIT(); asm volatile("" ::: "memory");
}
template <bool FULL> __device__ __forceinline__ void s5_sub(const bf16x8 (&Af)[8], const bf16x8 (&Cf)[4], const f32x4 d4, const bf16x8 Bf, const v2u u4raw, float& sr, float& si, float lbr, float lbi,
                                                            LAS float* Bu, LAS bf16* Sb, bf16* yrow, int lane) {
    s5_bu_to_lds(Af, Bf, Bu, lane);
    f32x2v b[16];
#pragma unroll
    for (int t = 0; t < 16; ++t) b[t] = *(const LAS f32x2v*)(Bu + t * 132 + 2 * lane);
#pragma unroll
    for (int t = 0; t < 16; ++t) { const float nsr = fmaf(lbr, sr, fmaf(-lbi, si, b[t].x)), nsi = fmaf(lbr, si, fmaf(lbi, sr, b[t].y)); sr = nsr; si = nsi;
        if (FULL) *(LAS unsigned*)(Sb + t * 136 + 2 * lane) = pk2(sr, si); }
    if (FULL) {
        LDS_WAIT(); asm volatile("" ::: "memory");
        f32x4 acc = (f32x4){0.f, 0.f, 0.f, 0.f};
#pragma unroll
        for (int kb = 0; kb < 4; ++kb) { const bf16x8 Sf = *(const LAS bf16x8*)(Sb + (lane & 15) * 136 + 32 * kb + 8 * (lane >> 4)); acc = MFMA16(Cf[kb], Sf, acc); }
        const float u0 = bf_lo(u4raw.x), u1 = bf_hi(u4raw.x), u2 = bf_lo(u4raw.y), u3 = bf_hi(u4raw.y);
        const float y0 = gelu_tanh(acc[0] + d4[0] * u0), y1 = gelu_tanh(acc[1] + d4[1] * u1), y2 = gelu_tanh(acc[2] + d4[2] * u2), y3 = gelu_tanh(acc[3] + d4[3] * u3);
        v2u o; o.x = pk2(y0, y1); o.y = pk2(y2, y3);
        *(GAS v2u*)(yrow + (size_t)(lane & 15) * D + 4 * (lane >> 4)) = o;
        asm volatile("" ::: "memory");
    }
}
__device__ __forceinline__ void s5_fast_group(const Args& a, int g, LAS unsigned char* L, int vcu, int G, int wave, int lane) {
    const bf16* U = (const bf16*)(a.ws + WS_U); bf16* YS5 = (bf16*)(a.ws + WS_YS5);
    LAS float* Bu = (LAS float*)(L + wave * S5_WLDS + S5_BU); LAS bf16* Sb = (LAS bf16*)(L + wave * S5_WLDS + S5_SB); LAS f32x2v* E = (LAS f32x2v*)(L + S5_E);
    float lbr, lbi, pwr, pwi;
    const float* S5C = (const float*)(a.ws + WS_S5C);
    { const f32x4 c0 = *(const f32x4*)(S5C + (size_t)(g * 64 + lane) * 8); const f32x2v c1 = *(const f32x2v*)(S5C + (size_t)(g * 64 + lane) * 8 + 4);
      lbr = c0[0]; lbi = c0[1]; pwr = c1.x; pwi = c1.y; }
    const bf16* ug = U + (size_t)g * M * 16; const int tw = wave * S5_SEG;
    LAS unsigned char* Us = L + wave * S5_WLDS + S5_US;
    const GAS v4u* useg = (const GAS v4u*)(ug + (size_t)tw * 16);
    const int bf_off = 32 * (lane & 15) + 16 * (lane >> 4), u4_off = 32 * (lane & 15) + 8 * (lane >> 4);
    {   LAS bf16* AP = (LAS bf16*)L;
#pragma unroll 1
        for (int tq = wave * S5_TQ; tq < (wave + 1) * S5_TQ; ++tq) { const int n = lane; const int e0 = 14 - 2 * tq;
          const f32x4 c0 = *(const f32x4*)(S5C + (size_t)(g * 64 + n) * 8);
          float pr = 1.f, pi = 0.f;
          for (int k = 0; k < e0; ++k) { const float r2 = pr * c0[0] - pi * c0[1], i2 = pr * c0[1] + pi * c0[0]; pr = r2; pi = i2; }
          const float qr = pr * c0[0] - pi * c0[1], qi = pr * c0[1] + pi * c0[0];
          const float* pbr = a.b_re + (size_t)(g * 64 + n) * 16; const float* pbi = a.b_im + (size_t)(g * 64 + n) * 16;
          LAS bf16* rre = AP + (32 * (n >> 4) + (n & 15)) * S5_APP + 32 * tq; LAS bf16* rim = rre + 16 * S5_APP;
#pragma unroll
          for (int q4 = 0; q4 < 4; ++q4) { const f32x4 br = *(const f32x4*)(pbr + 4 * q4), bi = *(const f32x4*)(pbi + 4 * q4);
              float xr[4], xi[4], yr[4], yi[4];
#pragma unroll
              for (int e = 0; e < 4; ++e) { const float bbr = c0[2] * br[e] - c0[3] * bi[e], bbi = c0[2] * bi[e] + c0[3] * br[e];
                  xr[e] = qr * bbr - qi * bbi; xi[e] = qr * bbi + qi * bbr; yr[e] = pr * bbr - pi * bbi; yi[e] = pr * bbi + pi * bbr; }
              *(LAS v2u*)(rre + 4 * q4) = (v2u){pk2(xr[0], xr[1]), pk2(xr[2], xr[3])}; *(LAS v2u*)(rim + 4 * q4) = (v2u){pk2(xi[0], xi[1]), pk2(xi[2], xi[3])};
              *(LAS v2u*)(rre + 16 + 4 * q4) = (v2u){pk2(yr[0], yr[1]), pk2(yr[2], yr[3])}; *(LAS v2u*)(rim + 16 + 4 * q4) = (v2u){pk2(yi[0], yi[1]), pk2(yi[2], yi[3])}; } }
        __syncthreads();
        float mur[4], mui[4], m13r[4], m13i[4], wqr[4], wqi[4];
#pragma unroll
        for (int mp = 0; mp < 4; ++mp) { const f32x2v lb = *(const f32x2v*)(S5C + (size_t)(g * 64 + 16 * mp + (lane & 15)) * 8);
            float r = lb.x, i = lb.y;
#pragma unroll
            for (int k = 0; k < 4; ++k) { const float r2 = r * r - i * i, i2 = 2.f * r * i; r = r2; i = i2; }
            const float m2r = r * r - i * i, m2i = 2.f * r * i, m4r = m2r * m2r - m2i * m2i, m4i = 2.f * m2r * m2i, m8r = m4r * m4r - m4i * m4i, m8i = 2.f * m4r * m4i;
            const float m12r = m8r * m4r - m8i * m4i, m12i = m8r * m4i + m8i * m4r;
            mur[mp] = r; mui[mp] = i; m13r[mp] = m12r; m13i[mp] = m12i;
            const int q = lane >> 4; wqr[mp] = q == 0 ? m12r : (q == 1 ? m8r : (q == 2 ? m4r : 1.f)); wqi[mp] = q == 0 ? m12i : (q == 1 ? m8i : (q == 2 ? m4i : 0.f)); }
        float zr[4] = {0.f, 0.f, 0.f, 0.f}, zi[4] = {0.f, 0.f, 0.f, 0.f};
#pragma unroll 1
        for (int nb = 0; nb < S5_NNB; ++nb) {
            bf16x8 Uf[8];
            const bf16* up = ug + (size_t)(tw + 16 * (16 * nb + (lane & 15))) * 16 + 8 * (lane >> 4);
#pragma unroll
            for (int kb = 0; kb < 8; ++kb) Uf[kb] = __builtin_bit_cast(bf16x8, *(const GAS v4u*)(up + 32 * kb));
            f32x4 acc[8];
#pragma unroll
            for (int mb = 0; mb < 8; ++mb) acc[mb] = (f32x4){0.f, 0.f, 0.f, 0.f};
#pragma unroll
            for (int kb = 0; kb < 8; ++kb)
#pragma unroll
                for (int mb = 0; mb < 8; ++mb) { const bf16x8 Af = *(const LAS bf16x8*)(AP + (16 * mb + (lane & 15)) * S5_APP + 32 * kb + 8 * (lane >> 4)); acc[mb] = MFMA16(Uf[kb], Af, acc[mb]); if (mb == 7) asm volatile("" ::: "memory"); }
#pragma unroll
            for (int mp = 0; mp < 4; ++mp) {
                if (nb > 0) { const float r2 = zr[mp] * m13r[mp] - zi[mp] * m13i[mp], i2 = zr[mp] * m13i[mp] + zi[mp] * m13r[mp]; zr[mp] = r2; zi[mp] = i2; }
#pragma unroll
                for (int r = 0; r < 4; ++r) { const float r2 = zr[mp] * mur[mp] - zi[mp] * mui[mp] + acc[2 * mp][r], i2 = zr[mp] * mui[mp] + zi[mp] * mur[mp] + acc[2 * mp + 1][r]; zr[mp] = r2; zi[mp] = i2; } }
        }
        __syncthreads();
#pragma unroll
        for (int mp = 0; mp < 4; ++mp) { float xr = zr[mp] * wqr[mp] - zi[mp] * wqi[mp], xi = zr[mp] * wqi[mp] + zi[mp] * wqr[mp];
            xr += __shfl_xor(xr, 16); xi += __shfl_xor(xi, 16); xr += __shfl_xor(xr, 32); xi += __shfl_xor(xi, 32);
            if (lane < 16) E[wave * 64 + 16 * mp + lane] = (f32x2v){xr, xi}; }
    }
    __syncthreads();
    float sr = 0.f, si = 0.f;
    for (int w2 = 0; w2 < wave; ++w2) { const f32x2v e = E[w2 * 64 + lane]; const float nsr = pwr * sr - pwi * si + e.x, nsi = pwr * si + pwi * sr + e.y; sr = nsr; si = nsi; }
    bf16x8 Af[8];
#pragma unroll
    for (int mb = 0; mb < 8; ++mb) {
        const int nr_ = 8 * mb + ((lane & 15) >> 1), part = lane & 1; v4u w = (v4u){0u, 0u, 0u, 0u};
        if (lane < 32) { const f32x2v cf = *(const f32x2v*)(S5C + (size_t)(g * 64 + nr_) * 8 + 2);
            const float* pr = a.b_re + (size_t)(g * 64 + nr_) * 16 + 8 * (lane >> 4); const float* pi = a.b_im + (size_t)(g * 64 + nr_) * 16 + 8 * (lane >> 4);
            const f32x4 r0 = *(const f32x4*)pr, r1 = *(const f32x4*)(pr + 4), i0 = *(const f32x4*)pi, i1 = *(const f32x4*)(pi + 4);
            f32x4 v0, v1;
#pragma unroll
            for (int e = 0; e < 4; ++e) { v0[e] = part ? (cf.x * i0[e] + cf.y * r0[e]) : (cf.x * r0[e] - cf.y * i0[e]); v1[e] = part ? (cf.x * i1[e] + cf.y * r1[e]) : (cf.x * r1[e] - cf.y * i1[e]); }
            w.x = pk2(v0[0], v0[1]); w.y = pk2(v0[2], v0[3]); w.z = pk2(v1[0], v1[1]); w.w = pk2(v1[2], v1[3]); }
        Af[mb] = __builtin_bit_cast(bf16x8, w);
    }
    bf16x8 Cf[4];
#pragma unroll
    for (int kb = 0; kb < 4; ++kb) { const int p = lane & 15, n0 = 16 * kb + 4 * (lane >> 4);
        const f32x4 cr4 = *(const f32x4*)(a.c_re + (size_t)(g * 16 + p) * 64 + n0), ci4 = *(const f32x4*)(a.c_im + (size_t)(g * 16 + p) * 64 + n0);
        v4u w; w.x = pk2(cr4[0], -ci4[0]); w.y = pk2(cr4[1], -ci4[1]); w.z = pk2(cr4[2], -ci4[2]); w.w = pk2(cr4[3], -ci4[3]); Cf[kb] = __builtin_bit_cast(bf16x8, w); }
    const f32x4 d4 = *(const f32x4*)(a.s5_d + g * 16 + 4 * (lane >> 4));
    asm volatile("" ::: "memory");
    { v4u R[4];
#pragma unroll
      for (int i = 0; i < 4; ++i) R[i] = useg[lane + 64 * i];
#pragma unroll 1
      for (int ch = 0; ch < S5_NCH; ++ch) {
#pragma unroll
          for (int i = 0; i < 4; ++i) *(LAS v4u*)(Us + 16 * (lane + 64 * i)) = R[i];
          LDS_WAIT(); asm volatile("" ::: "memory");
          const int chn = ch < S5_NCH - 1 ? ch + 1 : ch;
#pragma unroll
          for (int i = 0; i < 4; ++i) R[i] = useg[256 * chn + lane + 64 * i];
#pragma unroll 1
          for (int sb = 0; sb < 8; ++sb) {
              v4u bw = *(const LAS v4u*)(Us + 512 * sb + (lane < 32 ? bf_off : 0)); if (lane >= 32) bw = (v4u){0u, 0u, 0u, 0u};
              const v2u uw = *(const LAS v2u*)(Us + 512 * sb + u4_off);
              s5_sub<true>(Af, Cf, d4, __builtin_bit_cast(bf16x8, bw), uw, sr, si, lbr, lbi, Bu, Sb, YS5 + (size_t)(tw + 128 * ch + 16 * sb) * D + g * 16, lane);
          }
      } }
    p3_stream_items(a, L, (LAS bf16*)(L + wave * S5_WLDS), vcu, G, lane);
    __syncthreads();
}

__device__ __forceinline__ void p3_mem_role(const Args& a, LAS unsigned char* L, int vcu, int G, int wave, int lane) {
    __syncthreads(); __syncthreads(); __syncthreads();
    p3_stream_items(a, L, (LAS bf16*)(L + S5W * S5_WLDS + (wave - S5W) * TR_BYTES), vcu, G, lane);
    __syncthreads();
}
static_assert(S5W * S5_WLDS + (NWAVES - S5W) * TR_BYTES <= S5_E && S5W * S5_WLDS >= 128 * S5_APP * 2, "P3 LDS map: S5 per-wave regions / AP image, then the memory role's transpose scratch, then E");
constexpr size_t WS_BT = 872 * MiB, WS_ACUM = 888 * MiB, WS_CF = 892 * MiB, WS_SC = 1000 * MiB;
static_assert(WS_SC + (size_t)64 * 8 * 128 * 128 * 2 <= WS_H && WS_ACUM + (size_t)M * NH * 4 <= WS_CF && WS_CF + (size_t)64 * 8 * 16384 * 2 <= WS_SC, "ssd scratch map");
constexpr size_t WS_SSQ = 908 * MiB, WS_RT = 916 * MiB;
constexpr int SP_ROW = 136;
__device__ __forceinline__ void ssd_prep_dt(const Args& a, int item, LAS float* tot, int tid) {
    const float* DTP = a.out; float* DTS = (float*)(a.ws + WS_DTS); float* ACUM = (float*)(a.ws + WS_ACUM);
    const int c = item >> 2, h = 32 * (item & 3) + (tid & 31), q = tid >> 5;
    const float av = -expf(a.a_log[h]) * 1.44269504088896f, bias = a.dt_bias[h];
    float raw[8];
#pragma unroll
    for (int i = 0; i < 8; ++i) { const size_t idx = (size_t)(128 * c + 8 * q + i) * NH + h; float r = bias;
#pragma unroll
        for (int ks = 0; ks < 8; ++ks) r += DTP[(size_t)ks * M * NH + idx];
        raw[i] = r; }
    float loc[8]; float run = 0.f;
#pragma unroll
    for (int i = 0; i < 8; ++i) { const float dt = softplus_f(raw[i]); raw[i] = dt; run += dt * av; loc[i] = run; }
    { float* dp = DTS + (size_t)h * M + 128 * c + 8 * q; *(f32x4*)dp = (f32x4){raw[0], raw[1], raw[2], raw[3]}; *(f32x4*)(dp + 4) = (f32x4){raw[4], raw[5], raw[6], raw[7]}; }
    tot[q * 32 + (tid & 31)] = run;
    __syncthreads();
    float off = 0.f;
#pragma unroll
    for (int q2 = 0; q2 < 15; ++q2) off += (q2 < q) ? tot[q2 * 32 + (tid & 31)] : 0.f;
    { float* ap = ACUM + (size_t)h * M + 128 * c + 8 * q; *(f32x4*)ap = (f32x4){loc[0] + off, loc[1] + off, loc[2] + off, loc[3] + off}; *(f32x4*)(ap + 4) = (f32x4){loc[4] + off, loc[5] + off, loc[6] + off, loc[7] + off}; }
    __syncthreads();
}
template <int STAGE> __device__ __forceinline__ void ssd_prep_cg(const Args& a, int c, int g, LAS unsigned char* L, int tid, int wave, int lane) {
    const bf16* XBC = (const bf16*)(a.ws + WS_XBC); bf16* SC = (bf16*)(a.ws + WS_SC) + (size_t)(c * 8 + g) * 16384; bf16* BT = (bf16*)(a.ws + WS_BT) + (size_t)(c * 8 + g) * 16384; bf16* CF = (bf16*)(a.ws + WS_CF) + (size_t)(c * 8 + g) * 16384;
    LAS bf16* Bs = (LAS bf16*)L; LAS bf16* Cs = (LAS bf16*)(L + 128 * SP_ROW * 2);
    const int o = tid & 15;
    if constexpr (STAGE == 0) {
#pragma unroll
    for (int mat = 0; mat < 2; ++mat) {
        const int col0 = DI + mat * (NG * NS) + g * NS + 8 * o;
        f32x4 w0[4], w1[4];
#pragma unroll
        for (int k = 0; k < 4; ++k) { w0[k] = *(const f32x4*)(a.conv_w + k * CONVD + col0); w1[k] = *(const f32x4*)(a.conv_w + k * CONVD + col0 + 4); }
        const f32x4 b0 = *(const f32x4*)(a.conv_b + col0), b1 = *(const f32x4*)(a.conv_b + col0 + 4);
#pragma unroll
        for (int i = 0; i < 4; ++i) { const int tl = (tid >> 4) + 32 * i, t = 128 * c + tl;
            f32x4 acc0 = b0, acc1 = b1;
#pragma unroll
            for (int k = 0; k < 4; ++k) { const int tt = t - 3 + k;
                if (tt >= 0) { f32x4 r0, r1; pg8::unpack8(*(const GAS v4u*)(XBC + (size_t)tt * CONVD + col0), r0, r1); acc0 = acc0 + r0 * w0[k]; acc1 = acc1 + r1 * w1[k]; } }
#pragma unroll
            for (int e = 0; e < 4; ++e) { acc0[e] = pg8::silu_f(acc0[e]); acc1[e] = pg8::silu_f(acc1[e]); }
            v4u ov; ov.x = pk2(acc0.x, acc0.y); ov.y = pk2(acc0.z, acc0.w); ov.z = pk2(acc1.x, acc1.y); ov.w = pk2(acc1.z, acc1.w);
            *(LAS v4u*)((mat ? Cs : Bs) + tl * SP_ROW + 8 * o) = ov; }
    }
    } else {
    { f32x4 acc[8];
#pragma unroll
      for (int sb = 0; sb < 8; ++sb) acc[sb] = (f32x4){0.f, 0.f, 0.f, 0.f};
#pragma unroll
      for (int kb = 0; kb < 4; ++kb) { const bf16x8 cf = *(const LAS bf16x8*)(Cs + (16 * wave + (lane & 15)) * SP_ROW + 32 * kb + 8 * (lane >> 4));
          *(GAS v4u*)(CF + (size_t)((wave * 4 + kb) * 64 + lane) * 8) = __builtin_bit_cast(v4u, cf);
#pragma unroll
          for (int sb = 0; sb < 8; ++sb) { const bf16x8 bfr = *(const LAS bf16x8*)(Bs + (16 * sb + (lane & 15)) * SP_ROW + 32 * kb + 8 * (lane >> 4)); acc[sb] = MFMA16(bfr, cf, acc[sb]); } }
#pragma unroll
      for (int sb = 0; sb < 8; ++sb) { v2u ov; ov.x = pk2(acc[sb][0], acc[sb][1]); ov.y = pk2(acc[sb][2], acc[sb][3]);
          const int q = lane >> 4, lanep = (lane & 15) + 16 * (2 * (sb & 1) + (q >> 1));
          *(GAS v2u*)(SC + (size_t)((wave * 4 + (sb >> 1)) * 64 + lanep) * 8 + 4 * (q & 1)) = ov; } }
#pragma unroll
    for (int kb = 0; kb < 4; ++kb) { unsigned short v[8];
#pragma unroll
        for (int e = 0; e < 8; ++e) v[e] = Bs[(32 * kb + 8 * (lane >> 4) + e) * SP_ROW + 16 * wave + (lane & 15)];
        v4u ov; ov.x = v[0] | ((unsigned)v[1] << 16); ov.y = v[2] | ((unsigned)v[3] << 16); ov.z = v[4] | ((unsigned)v[5] << 16); ov.w = v[6] | ((unsigned)v[7] << 16);
        *(GAS v4u*)(BT + (size_t)((wave * 4 + kb) * 64 + lane) * 8) = ov; }
    }
}
constexpr int PREP_LDS = 2 * 128 * SP_ROW * 2;
constexpr int SM_XD = 0, SM_XW = 8192, SM_XP = 16384, SM_ZP = 24576, SM_AC = 32768, SM_XE = 33280, SM_BUF = 41472, SM_SB = 2 * SM_BUF, SM_SBSZ = 8704;
typedef short s16x4 __attribute__((ext_vector_type(4)));
__device__ __forceinline__ bf16x8 ssd_tr_frag(const LAS unsigned char* img, int kb, int pb, int lane) {
    const LAS unsigned char* ad = img + (32 * kb + 8 * (lane >> 4) + ((lane & 15) >> 2)) * 64 + (16 * pb + 4 * (lane & 3)) * 2;
    const s16x4 lo = __builtin_amdgcn_ds_read_tr16_b64_v4i16((LAS s16x4*)ad), hi = __builtin_amdgcn_ds_read_tr16_b64_v4i16((LAS s16x4*)(ad + 4 * 64));
    return __builtin_shufflevector(lo, hi, 0, 1, 2, 3, 4, 5, 6, 7);
}
__device__ __forceinline__ bf16x8 ssd_tr_frag_y(const LAS unsigned char* img, int kb, int pb, int lane) {
    const LAS unsigned char* ad = img + (32 * kb + 8 * (lane >> 4) + ((lane & 15) >> 2)) * 64 + (8 * (lane & 3) + 4 * pb) * 2;
    const s16x4 lo = __builtin_amdgcn_ds_read_tr16_b64_v4i16((LAS s16x4*)ad), hi = __builtin_amdgcn_ds_read_tr16_b64_v4i16((LAS s16x4*)(ad + 4 * 64));
    return __builtin_shufflevector(lo, hi, 0, 1, 2, 3, 4, 5, 6, 7);
}
struct SsdStage { v4u x, z; float dt, ac, acend, acb; };
__device__ __forceinline__ void ssd_stage_load(SsdStage& s, const bf16* XC, const bf16* MZ, const float* DTS, const float* ACUM, int c, int h, int ph, int tid) {
    const int t = 128 * c + (tid >> 2), piece = tid & 3;
    s.x = __builtin_nontemporal_load((const GAS v4u*)(XC + (size_t)t * CONVD + h * HD + 32 * ph + 8 * piece));
    s.z = __builtin_nontemporal_load((const GAS v4u*)(MZ + (size_t)t * DI + h * HD + 32 * ph + 8 * piece));
    s.dt = DTS[(size_t)h * M + t]; s.ac = ACUM[(size_t)h * M + t]; s.acend = ACUM[(size_t)h * M + 128 * c + 127]; s.acb = ACUM[(size_t)h * M + 128 * c + ((tid >> 2) | 31)];
}
__device__ __forceinline__ void ssd_stage_store(const SsdStage& s, LAS unsigned char* buf, int tid) {
    const int tl = tid >> 2, piece = tid & 3;
    const float te = __builtin_amdgcn_exp2f(s.acend - s.ac), tb = __builtin_amdgcn_exp2f(s.acb - s.ac);
    const unsigned xs[4] = {s.x.x, s.x.y, s.x.z, s.x.w}; unsigned d[4], w[4], eb[4];
#pragma unroll
    for (int e2 = 0; e2 < 4; ++e2) { const float x0 = bf_lo(xs[e2]) * s.dt, x1 = bf_hi(xs[e2]) * s.dt; d[e2] = pk2(x0, x1); w[e2] = pk2(x0 * te, x1 * te); eb[e2] = pk2(x0 * tb, x1 * tb); }
    *(LAS v4u*)(buf + SM_XE + tl * 64 + 16 * piece) = (v4u){eb[0], eb[1], eb[2], eb[3]};
    *(LAS v4u*)(buf + SM_XD + tl * 64 + 16 * piece) = (v4u){d[0], d[1], d[2], d[3]};
    *(LAS v4u*)(buf + SM_XW + tl * 64 + 16 * piece) = (v4u){w[0], w[1], w[2], w[3]};
    *(LAS v4u*)(buf + SM_XP + tl * 64 + 16 * piece) = s.x;
    *(LAS v4u*)(buf + SM_ZP + tl * 64 + 16 * piece) = s.z;
    if (piece == 0) *(LAS float*)(buf + SM_AC + 4 * tl) = s.ac;
}
struct SsdFrags { bf16x8 sc[3], scd, cc[4], bt[4]; };
__device__ __forceinline__ void ssd_frag_load(SsdFrags& f, const bf16* SC, const bf16* CF, const bf16* BT, int c, int g, int wave, int lane) {
    const size_t base = ((size_t)((c * 8 + g) * 8 + wave) * 4 * 64 + lane) * 8; const int kd = wave >> 1;
#pragma unroll
    for (int kb = 0; kb < 4; ++kb) { if (kb < 3) { if (kb < kd) f.sc[kb] = __builtin_bit_cast(bf16x8, *(const GAS v4u*)(SC + base + kb * 512)); } else f.scd = __builtin_bit_cast(bf16x8, *(const GAS v4u*)(SC + base + kd * 512));
        f.cc[kb] = __builtin_bit_cast(bf16x8, *(const GAS v4u*)(CF + base + kb * 512)); f.bt[kb] = __builtin_bit_cast(bf16x8, *(const GAS v4u*)(BT + base + kb * 512)); }
}
#define SSD_BAR() do { LDS_WAIT(); asm volatile("" ::: "memory"); __builtin_amdgcn_s_barrier(); asm volatile("" ::: "memory"); } while (0)
template <int DBG> __device__ __forceinline__ void ssd_chunk(const SsdFrags& fr, SsdFrags& frn, const SsdStage& sgs, SsdStage& sgl, f32x4 (&st)[2], int c, int cn, int cl, const bf16* XC, const bf16* MZ, const float* DTS, const float* ACUM, const bf16* SC, const bf16* CF, const bf16* BT, bf16* YSSD, float* SSQ,
                                          int h, int ph, int g, float Dh, LAS unsigned char* L, int tid, int wave, int lane, bool late) {
    LAS unsigned char* buf = L + (c & 1) * SM_BUF; LAS unsigned char* nbuf = L + ((c + 1) & 1) * SM_BUF;
    const LAS bf16* SBo = (const LAS bf16*)(L + SM_SB + (c & 1) * SM_SBSZ); LAS bf16* SBn = (LAS bf16*)(L + SM_SB + ((c + 1) & 1) * SM_SBSZ);
    const LAS unsigned char* XD = buf + SM_XD; const LAS unsigned char* XW = buf + SM_XW; const LAS float* AC = (const LAS float*)(buf + SM_AC);
    if (!(DBG & 2)) ssd_frag_load(frn, SC, CF, BT, cn, g, wave, lane);
    if (!(DBG & 4)) ssd_stage_load(sgl, XC, MZ, DTS, ACUM, cl, h, ph, tid);
    const int trow = 16 * wave + (lane & 15), ko = 8 * (lane >> 4), kd = wave >> 1;
    auto state_and_stage = [&]() __attribute__((always_inline)) {
    { const float dec = __builtin_amdgcn_exp2f(AC[127]); st[0] = st[0] * dec; st[1] = st[1] * dec;
      if (!(DBG & 16))
#pragma unroll
      for (int kb = 0; kb < 4; ++kb)
#pragma unroll
          for (int pb = 0; pb < 2; ++pb) { const bf16x8 Bf = ssd_tr_frag(XW, kb, pb, lane); st[pb] = MFMA16(fr.bt[kb], Bf, st[pb]); }
#pragma unroll
      for (int pb = 0; pb < 2; ++pb) { v2u ov; ov.x = pk2(st[pb][0], st[pb][1]); ov.y = pk2(st[pb][2], st[pb][3]); *(LAS v2u*)(SBn + (16 * pb + (lane & 15)) * SP_ROW + 16 * wave + 4 * (lane >> 4)) = ov; } }
    if (!(DBG & 8)) ssd_stage_store(sgs, nbuf, tid); };
    if (late) state_and_stage();
    const LAS unsigned char* XE = buf + SM_XE;
    bf16x8 Sf[4][2];
#pragma unroll
    for (int kb = 0; kb < 4; ++kb)
#pragma unroll
        for (int pb = 0; pb < 2; ++pb) Sf[kb][pb] = *(const LAS bf16x8*)(SBo + (8 * ((lane & 15) >> 2) + 4 * pb + (lane & 3)) * SP_ROW + 32 * kb + ko);
    const float act = AC[trow];
    const f32x4 as0 = *(const LAS f32x4*)(AC + 32 * kd + ko), as1 = *(const LAS f32x4*)(AC + 32 * kd + ko + 4);
    const float ae0 = AC[31], ae1 = AC[63], ae2 = AC[95];
    const v4u xv = *(const LAS v4u*)(buf + SM_XP + trow * 64 + 16 * (lane >> 4)), zv = *(const LAS v4u*)(buf + SM_ZP + trow * 64 + 16 * (lane >> 4));
    const v2u xw[2] = {(v2u){xv.x, xv.y}, (v2u){xv.z, xv.w}}, zw[2] = {(v2u){zv.x, zv.y}, (v2u){zv.z, zv.w}};
    const f32x4 zero4 = (f32x4){0.f, 0.f, 0.f, 0.f};
    f32x4 accD[2] = {zero4, zero4}, accO[2] = {zero4, zero4}, P[3][2];
    if (!(DBG & 16))
#pragma unroll
    for (int kb = 0; kb < 4; ++kb)
#pragma unroll
        for (int pb = 0; pb < 2; ++pb) accO[pb] = MFMA16(Sf[kb][pb], fr.cc[kb], accO[pb]);
#pragma unroll
    for (int kb = 0; kb < 3; ++kb) if (kb < kd && !(DBG & 16)) {
#pragma unroll
        for (int pb = 0; pb < 2; ++pb) P[kb][pb] = MFMA16(ssd_tr_frag_y(XE, kb, pb, lane), fr.sc[kb], zero4); }
    if (!(DBG & 16)) { const v4u sw = __builtin_bit_cast(v4u, fr.scd); const unsigned sws[4] = {sw.x, sw.y, sw.z, sw.w}; unsigned ow[4];
      const int dl = 16 * (wave & 1) + (lane & 15) - ko;
#pragma unroll
      for (int e2 = 0; e2 < 4; ++e2) { const float a0 = e2 < 2 ? as0[2 * e2] : as1[2 * e2 - 4], a1 = e2 < 2 ? as0[2 * e2 + 1] : as1[2 * e2 - 3];
          float v0 = bf_lo(sws[e2]) * __builtin_amdgcn_exp2f(act - a0), v1 = bf_hi(sws[e2]) * __builtin_amdgcn_exp2f(act - a1);
          v0 = (2 * e2 <= dl) ? v0 : 0.f; v1 = (2 * e2 + 1 <= dl) ? v1 : 0.f;
          ow[e2] = pk2(v0, v1); }
      const bf16x8 Lf = __builtin_bit_cast(bf16x8, ((v4u){ow[0], ow[1], ow[2], ow[3]}));
#pragma unroll
      for (int pb = 0; pb < 2; ++pb) { const bf16x8 Xf = ssd_tr_frag_y(XD, kd, pb, lane); accD[pb] = MFMA16(Xf, Lf, accD[pb]); } }
    { const float ea = __builtin_amdgcn_exp2f(act); float ssq = 0.f;
      const float aes[3] = {ae0, ae1, ae2};
#pragma unroll
      for (int kb = 0; kb < 3; ++kb) if (kb < kd && !(DBG & 16)) { const float r = __builtin_amdgcn_exp2f(act - aes[kb]);
#pragma unroll
          for (int pb = 0; pb < 2; ++pb) accD[pb] = accD[pb] + r * P[kb][pb]; }
      unsigned yo[4];
#pragma unroll
      for (int pb = 0; pb < 2; ++pb) {
          const float y0 = (accD[pb][0] + ea * accO[pb][0] + Dh * bf_lo(xw[pb].x)) * bf_lo(zw[pb].x), y1 = (accD[pb][1] + ea * accO[pb][1] + Dh * bf_hi(xw[pb].x)) * bf_hi(zw[pb].x);
          const float y2 = (accD[pb][2] + ea * accO[pb][2] + Dh * bf_lo(xw[pb].y)) * bf_lo(zw[pb].y), y3 = (accD[pb][3] + ea * accO[pb][3] + Dh * bf_hi(xw[pb].y)) * bf_hi(zw[pb].y);
          ssq += (y0 * y0 + y1 * y1) + (y2 * y2 + y3 * y3);
          yo[2 * pb] = pk2(y0, y1); yo[2 * pb + 1] = pk2(y2, y3); }
      if (!(DBG & 1)) __builtin_nontemporal_store(((v4u){yo[0], yo[1], yo[2], yo[3]}), (GAS v4u*)(YSSD + (size_t)(128 * c + trow) * DI + h * HD + 32 * ph + 8 * (lane >> 4)));
      ssq += __shfl_xor(ssq, 16); ssq += __shfl_xor(ssq, 32);
      if (lane < 16 && !(DBG & 32)) SSQ[((size_t)(8 * c + wave) * 256 + 2 * h + ph) * 16 + lane] = ssq; }
    if (!late) state_and_stage();
    SSD_BAR();
}
template <int DBG> __device__ __forceinline__ void ssd_main_item(const Args& a, int item, LAS unsigned char* L, int tid, int wave, int lane) {
    const bf16* XC = (const bf16*)(a.ws + WS_XC); const bf16* MZ = (const bf16*)(a.ws + WS_MZ); const float* DTS = (const float*)(a.ws + WS_DTS); const float* ACUM = (const float*)(a.ws + WS_ACUM);
    const bf16* SC = (const bf16*)(a.ws + WS_SC); const bf16* BT = (const bf16*)(a.ws + WS_BT); const bf16* CF = (const bf16*)(a.ws + WS_CF); bf16* YSSD = (bf16*)(a.ws + WS_YSSD); float* SSQ = (float*)(a.ws + WS_SSQ);
    const int h = item >> 1, ph = item & 1, g = h >> 4; const float Dh = a.m2_d[h];
    const int wave_hw = wave; wave = wave_hw < 4 ? 7 - wave_hw : wave_hw - 4;
    for (int i = tid; i < SM_SBSZ / 4; i += NWAVES * 64) *(LAS unsigned*)(L + SM_SB + 4 * i) = 0u;
    SsdStage sgE, sgO; SsdFrags frA, frB;
    ssd_stage_load(sgE, XC, MZ, DTS, ACUM, 0, h, ph, tid); ssd_frag_load(frA, SC, CF, BT, 0, g, wave, lane);
    ssd_stage_load(sgO, XC, MZ, DTS, ACUM, 1, h, ph, tid);
    ssd_stage_store(sgE, L, tid);
    f32x4 st[2] = {(f32x4){0.f, 0.f, 0.f, 0.f}, (f32x4){0.f, 0.f, 0.f, 0.f}};
    __syncthreads();
    const bool late = false;
#pragma unroll 1
    for (int c = 0; c < 64; c += 2) {
        ssd_chunk<DBG>(frA, frB, sgO, sgE, st, c, c + 1, c + 2 < 64 ? c + 2 : 63, XC, MZ, DTS, ACUM, SC, CF, BT, YSSD, SSQ, h, ph, g, Dh, L, tid, wave, lane, late);
        ssd_chunk<DBG>(frB, frA, sgE, sgO, st, c + 1, c + 2 < 64 ? c + 2 : 63, c + 3 < 64 ? c + 3 : 63, XC, MZ, DTS, ACUM, SC, CF, BT, YSSD, SSQ, h, ph, g, Dh, L, tid, wave, lane, late);
    }
    __syncthreads();
}

__device__ __forceinline__ void ssd_norm_stats(const Args& a, size_t gt, size_t NT) {
    const float* SSQ = (const float*)(a.ws + WS_SSQ); float* RT = (float*)(a.ws + WS_RT);
    for (size_t idx = gt; idx < (size_t)M * NG; idx += NT) {
        const int t = (int)(idx >> 6) * 8 + (int)(idx & 7), g = (int)(idx >> 3) & 7;
        const float* sp = SSQ + ((size_t)(t >> 4) * 256 + 32 * g) * 16 + (t & 15);
        float s = 0.f;
#pragma unroll 8
        for (int j = 0; j < 32; ++j) s += sp[j * 16];
        const float r = 1.0f / sqrtf(s * (1.0f / 1024.0f) + EPS);
        const float rn = __shfl_down(r, 8);
        RT[(size_t)t * 8 + g] = (g == 7) ? r : r / rn;
    }
}
__global__ void __launch_bounds__(NWAVES * 64, 2) hyb_fwd(Args args) {
    extern __shared__ __attribute__((aligned(16))) unsigned char lds[];
    LAS unsigned char* L = (LAS unsigned char*)lds;
    volatile LAS unsigned* MISC = (volatile LAS unsigned*)(L + MISC_OFF);
    const int tid = threadIdx.x, lane = tid & 63, wave = __builtin_amdgcn_readfirstlane(tid >> 6);
    const int G = gridDim.x; const int bx = blockIdx.x; const int vcu = (G % 8 == 0) ? (bx % 8) * (G / 8) + bx / 8 : bx;
    const int gw = vcu * NWAVES + wave, NGW = G * NWAVES;
    gu32* ctl = (gu32*)(args.ws + WS_CTL);
    for (int u = tid; u < (LDS_BYTES - LDSCTL_OFF) / 4; u += NWAVES * 64) ((LAS unsigned*)(L + LDSCTL_OFF))[u] = 0u;
    __syncthreads();
    XcdBarrier bar; bar.bar = (unsigned*)(ctl + CW_BAR); bar.x = 0; bar.st = nullptr;
    if (N_LAUNCHES == 1) bar = xcd_barrier_post((unsigned*)(ctl + CW_BAR), MISC + 8);
#define GRID_BAR() do { if (N_LAUNCHES == 1) xcd_barrier(bar); } while (0)
    const int lo = args.ph_lo, hi = args.ph_hi;
#define IN(k) (lo <= (k) && (k) < hi)
#define BOTH(k) (IN(k) && IN((k) + 1))
#if defined(PROBE_PHASE)
#define PROBE_DBG(x) (x)
#else
#define PROBE_DBG(x) 0
#endif
#define LAUNDER() int lane_p = lane, tid_p = tid; asm volatile("" : "+v"(lane_p), "+v"(tid_p))

    if (IN(0)) {
        LAUNDER();
        p0_gemv(args.c, args.w_ada, (float*)(args.ws + WS_MODP), (LAS float*)(L + RING_OFF), vcu, G, tid_p);
        p0_weights_in(args, (LAS bf16*)(L + RING_OFF + wave * 16384), gw, NGW, lane_p);
        s5_consts(args, (size_t)gw * 64 + lane_p, (size_t)NGW * 64);
        if (BOTH(0)) GRID_BAR();
    }
    if (IN(1)) {
        LAUNDER();
        p1_h(args, (LAS float*)(L + RING_OFF), (LAS float*)(L + RING_OFF + 16384), gw, NGW, tid_p, lane_p);
        if (BOTH(1)) GRID_BAR();
    }
    if (IN(2)) {
        { pg8::Gemm g{(const bf16*)(args.ws + WS_H), (const bf16*)(args.ws + WS_WIN), M, NMAIN, D, D}; pg8::StaticOrder S; S.init(M, NMAIN, G, bx);
          pg8::EpiProj E{(bf16*)(args.ws + WS_U), (bf16*)(args.ws + WS_SZ), (bf16*)(args.ws + WS_MZ), (bf16*)(args.ws + WS_XBC), (bf16*)(args.ws + WS_G1), (bf16*)(args.ws + WS_G2)};
          pg8::gemm_phase<pg8::EpiProj, pg8::StaticOrder, PG8_ALIGN, PG8_SP2>(L + RING_OFF, g, S, E); }
        { pg8::Gemm g{(const bf16*)(args.ws + WS_H), (const bf16*)(args.ws + WS_WIN) + (size_t)NMAIN * D, M, 8 * 256, 512, D}; pg8::StaticOrder S; S.init(M, 8 * 256, G, bx);
          pg8::EpiDTP E{args.out};
          pg8::gemm_phase<pg8::EpiDTP, pg8::StaticOrder, PG8_ALIGN, PG8_SP2, true>(L + RING_OFF, g, S, E); }
        if (BOTH(2)) GRID_BAR();
    }
    if (IN(3)) {
        LAUNDER();
        const int sub = args.sub;
        if (tid_p == 0) *(LAS unsigned*)(L + RING_OFF + P3_CNT_OFF) = (sub == 5) ? 0x100000u : 0u;
        if (sub == 0 || sub == 2) for (int it = vcu; it < 64 * NG; it += 2 * G) {
            const int it2 = it + G; const bool two = it2 < 64 * NG;
            ssd_prep_cg<0>(args, it >> 3, it & 7, L + RING_OFF, tid_p, wave, lane_p);
            if (two) ssd_prep_cg<0>(args, it2 >> 3, it2 & 7, L + RING_OFF + PREP_LDS, tid_p, wave, lane_p);
            __syncthreads();
            ssd_prep_cg<1>(args, it >> 3, it & 7, L + RING_OFF, tid_p, wave, lane_p);
            if (two) ssd_prep_cg<1>(args, it2 >> 3, it2 & 7, L + RING_OFF + PREP_LDS, tid_p, wave, lane_p);
            __syncthreads(); }
        if (sub == 0 || sub == 3) for (int it = vcu; it < 64 * 4; it += G) ssd_prep_dt(args, it, (LAS float*)(L + RING_OFF), tid_p);
        if (sub == 0 || sub == 1 || sub == 5) for (int g5 = vcu; g5 < S5G; g5 += G) {
            if (wave < S5W) s5_fast_group(args, g5, L + RING_OFF, vcu, G, wave, lane_p);
            else p3_mem_role(args, L + RING_OFF, vcu, G, wave, lane_p); }
        if (BOTH(3)) GRID_BAR();
    }
    if (IN(4)) { LAUNDER(); for (int it = vcu; it < NH * 2; it += G) {
#if defined(PROBE_PHASE) && PROBE_PHASE == 4
            if (args.sub) ssd_main_item<PROBE_SUB>(args, it, L + RING_OFF, tid_p, wave, lane_p); else
#endif
            ssd_main_item<0>(args, it, L + RING_OFF, tid_p, wave, lane_p); } if (BOTH(4)) GRID_BAR(); }
    if (IN(5)) { LAUNDER(); ssd_norm_stats(args, (size_t)gw * 64 + lane_p, (size_t)NGW * 64); }
    if (IN(6)) {
        pg8::Gemm g{(const bf16*)(args.ws + WS_YS5), (const bf16*)(args.ws + WS_WGLU), M, 8192, D, D}; pg8::StaticOrder S; S.init(M, 8192, G, bx);
        pg8::EpiGlu E{(const bf16*)(args.ws + WS_SZ), args.b_glu, (bf16*)(args.ws + WS_YS5G)};
        pg8::gemm_phase<pg8::EpiGlu, pg8::StaticOrder, PG8_ALIGN, PG8_SP2>(L + RING_OFF, g, S, E);
        if (BOTH(6)) GRID_BAR();
    }
    if (IN(7)) {
        pg8::Gemm g{(const bf16*)(args.ws + WS_YS5G), (const bf16*)(args.ws + WS_WBRS), M, D, D, D}; pg8::StaticOrder S; S.init(M, D, G, bx);
        pg8::EpiBrS E{(const bf16*)(args.ws + WS_G1), (bf16*)(args.ws + WS_T1)};
        pg8::gemm_phase<pg8::EpiBrS, pg8::StaticOrder, PG8_ALIGN, PG8_SP2>(L + RING_OFF, g, S, E);
    }
    if (IN(8)) {
        pg8::Gemm g{(const bf16*)(args.ws + WS_YSSD), (const bf16*)(args.ws + WS_WBRM), M, D, DI, DI}; pg8::StaticOrder S; S.init(M, D, G, bx);
        pg8::EpiBrM E{(const bf16*)(args.ws + WS_G2), (const bf16*)(args.ws + WS_T1), (bf16*)(args.ws + WS_MERGED), (const float*)(args.ws + WS_RT)};
        pg8::gemm_phase<pg8::EpiBrM, pg8::StaticOrder, PG8_ALIGN, PG8_SP2>(L + RING_OFF, g, S, E);
        if (BOTH(8)) GRID_BAR();
    }
    if (IN(9)) {
        pg8::Gemm g{(const bf16*)(args.ws + WS_MERGED), (const bf16*)(args.ws + WS_WOUT), M, D, D, D}; pg8::StaticOrder S; S.init(M, D, G, bx);
        pg8::EpiOut E{args.x, (const float*)(args.ws + WS_GATE), (bf16*)(args.ws + WS_X2), (float*)(args.ws + WS_SS)};
        pg8::gemm_phase<pg8::EpiOut, pg8::StaticOrder, PG8_ALIGN, PG8_SP2>(L + RING_OFF, g, S, E);
        if (BOTH(9)) GRID_BAR();
    }
    if (IN(10)) { LAUNDER(); final_norm(args, gw, NGW, lane_p); }

#if defined(DBG_STOP)
    if (IN(NPH)) {
        const size_t gt = (size_t)gw * 64 + lane, NT = (size_t)NGW * 64; const size_t R = (size_t)8 << 20;
        const unsigned char* b0 = args.ws + DBG_B0; const unsigned char* b1 = args.ws + DBG_B1; const unsigned char* b2 = args.ws + DBG_B2; const unsigned char* b3 = args.ws + DBG_B3;
        for (size_t i = gt; i < R; i += NT) {
            float s0 = 0.f, s1 = 0.f, s2 = 0.f, s3 = 0.f;
            for (size_t j = i; j < (size_t)DBG_N0; j += R) s0 += DBG_F0 ? ((const float*)b0)[j] : bf2f(((const bf16*)b0)[j]);
            for (size_t j = i; j < (size_t)DBG_N1; j += R) s1 += DBG_F1 ? ((const float*)b1)[j] : bf2f(((const bf16*)b1)[j]);
            for (size_t j = i; j < (size_t)DBG_N2; j += R) s2 += DBG_F2 ? ((const float*)b2)[j] : bf2f(((const bf16*)b2)[j]);
            for (size_t j = i; j < (size_t)DBG_N3; j += R) s3 += DBG_F3 ? ((const float*)b3)[j] : bf2f(((const bf16*)b3)[j]);
            args.out[i] = s0 * 1e9f; args.out[R + i] = s1 * 1e6f; args.out[2 * R + i] = s2 * 1e3f; args.out[3 * R + i] = s3;
        }
    }
#endif
#undef IN
#undef BOTH
}

extern "C" void kernel_launch(void* const* d_in, const int* in_sizes, int n_in, void* d_out, int out_size, void* d_ws, size_t ws_size, hipStream_t stream) {
    static int grid = 0;
    if (grid == 0) {
        if (n_in != 26 || in_sizes[0] != M * D || out_size != M * D || ws_size < WS_END) { fprintf(stderr, "kernel_launch: built for 26 inputs, x/out of %d floats, >= %zu bytes of workspace; got n_in %d, in0 %d, out %d, ws %zu; nothing launched\n", M * D, (size_t)WS_END, n_in, n_in > 0 ? in_sizes[0] : -1, out_size, ws_size); grid = -1; return; }
        int dev = 0, cus = 0, per_cu = 0;
        if (hipGetDevice(&dev) != hipSuccess || hipDeviceGetAttribute(&cus, hipDeviceAttributeMultiprocessorCount, dev) != hipSuccess) { fprintf(stderr, "kernel_launch: hipGetDevice / hipDeviceGetAttribute failed\n"); grid = -1; return; }
        if (hipFuncSetAttribute((const void*)hyb_fwd, hipFuncAttributeMaxDynamicSharedMemorySize, LDS_BYTES) != hipSuccess) { fprintf(stderr, "kernel_launch: hipFuncSetAttribute failed\n"); grid = -1; return; }
        if (hipOccupancyMaxActiveBlocksPerMultiprocessor(&per_cu, (const void*)hyb_fwd, NWAVES * 64, LDS_BYTES) != hipSuccess || per_cu < 1)
            fprintf(stderr, "kernel_launch: note: the occupancy query reports %d workgroups per CU\n", per_cu);
        (void)hipGetLastError();
        grid = cus;
    }
    if (grid < 0) return;
    if (hipMemsetAsync((char*)d_ws + WS_CTL, 0, CTL_ZERO_BYTES, stream) != hipSuccess) { fprintf(stderr, "kernel_launch: hipMemsetAsync failed\n"); return; }
    Args a{};
    const float** ap = (const float**)&a;
    for (int i = 0; i < 26; ++i) ap[i] = (const float*)d_in[i];
    a.out = (float*)d_out; a.ws = (unsigned char*)d_ws;
#if defined(DBG_STOP)
    const int nl = DBG_STOP + 2;
#else
    const int nl = N_LAUNCHES;
#endif
    for (int li = 0; li < nl; ++li) {
        a.ph_lo = (N_LAUNCHES == 1) ? 0 : li; a.ph_hi = (N_LAUNCHES == 1) ? NPH : li + 1;
#if defined(DBG_STOP)
        if (li == nl - 1) { a.ph_lo = NPH; a.ph_hi = NPH + 1; }
#endif
        hipLaunchKernelGGL(hyb_fwd, dim3(grid), dim3(NWAVES * 64), LDS_BYTES, stream, a);
        const hipError_t le = hipPeekAtLastError();
        if (le != hipSuccess) { fprintf(stderr, "kernel_launch: launch %d failed: %s\n", li, hipGetErrorName(le)); break; }
    }
#if defined(PROBE_PHASE)
    a.ph_lo = PROBE_PHASE; a.ph_hi = PROBE_PHASE + 1; a.sub = PROBE_SUB;
    hipLaunchKernelGGL(hyb_fwd, dim3(grid), dim3(NWAVES * 64), LDS_BYTES, stream, a);
#endif
}
```

```cpp
#include <hip/hip_runtime.h>
#include <cstdio>
#include <cstdint>
namespace pg8 {
#define PG8_LAS __attribute__((address_space(3)))
typedef unsigned short bf16_t;
typedef short bf16x8 __attribute__((ext_vector_type(8)));
typedef float f32x4 __attribute__((ext_vector_type(4)));
typedef unsigned u32x4 __attribute__((ext_vector_type(4)));
constexpr int BM = 256, BK = 64, HALF = 128, HTB = HALF * BK * 2  , STAGE_BYTES = 8 * HTB, NXCD = 8, WGM = 4;

__host__ __device__ __forceinline__ int lds_byte(int r, int c) { const int st = (r >> 4) * 2 + (c >> 5), rr = r & 15, cc = c & 31, ob = rr * 64 + cc * 2; return st * 1024 + (ob ^ (((ob >> 9) & 1) << 5)); }
__host__ __device__ __forceinline__ void stage_rc(int b, int& R, int& C) { const int st = b / 1024, sb = b % 1024, swz = sb ^ (((sb >> 9) & 1) << 5); R = (st >> 1) * 16 + swz / 64; C = (st & 1) * 32 + (swz % 64) / 2; }
__host__ __device__ __forceinline__ int perm32(int rho) { const int n = rho >> 4, i = rho & 15; return 8 * (i >> 2) + 4 * n + (i & 3); }

struct Unit { int pm, pn; };
struct Gemm { const bf16_t* A; const bf16_t* Bt; int M, N, K, ld; };

struct StaticOrder {
    int nM, nN, nwg, G, c;
    __host__ __device__ void init(int M, int N, int G_, int c_) { nM = M / BM; nN = N / BM; nwg = nM * nN; G = G_; c = c_; }
    __host__ __device__ bool next(int i, Unit& u) const {
        const long L = (long)i * G + c; if (L >= nwg) return false;
        int wgid = (int)L; { const int q = nwg / NXCD, r = nwg % NXCD, xcd = wgid % NXCD, off = wgid / NXCD; wgid = (xcd < r ? xcd * (q + 1) : r * (q + 1) + (xcd - r) * q) + off; }
        const int nig = WGM * nN, gid = wgid / nig, fm = gid * WGM, gsz = (nM - fm) < WGM ? (nM - fm) : WGM;
        u.pm = fm + ((wgid % nig) % gsz); u.pn = (wgid % nig) / gsz; return true;
    }
    __device__ __forceinline__ void a_ready(const Unit&) const {}
    __device__ __forceinline__ void done(const Unit&) const {}
};
typedef float f32x2c_ __attribute__((ext_vector_type(2)));
typedef __bf16 bf16x2c_ __attribute__((ext_vector_type(2)));
__device__ __forceinline__ unsigned cvt_pk_bf16(float lo, float hi) { return __builtin_bit_cast(unsigned, __builtin_convertvector(((f32x2c_){lo, hi}), bf16x2c_)); }
#define EPI_MFMA_SETTLE() do {} while (0)
__device__ __forceinline__ float bf_lo(unsigned w) { return __builtin_bit_cast(float, w << 16); }
__device__ __forceinline__ float bf_hi(unsigned w) { return __builtin_bit_cast(float, w & 0xffff0000u); }
__device__ __forceinline__ float sigmoid_f(float v) { return __builtin_amdgcn_rcpf(1.0f + __expf(-v)); }
__device__ __forceinline__ float silu_f(float v) { return v * sigmoid_f(v); }
template <int ACT> __device__ __forceinline__ float act_f(float v) { if (ACT == 1) return silu_f(v); if (ACT == 2) return sigmoid_f(v); return v; }
__device__ __forceinline__ u32x4 pack8(const f32x4& v0, const f32x4& v1) { u32x4 w; w.x = cvt_pk_bf16(v0[0], v0[1]); w.y = cvt_pk_bf16(v0[2], v0[3]); w.z = cvt_pk_bf16(v1[0], v1[1]); w.w = cvt_pk_bf16(v1[2], v1[3]); return w; }
__device__ __forceinline__ void unpack8(const u32x4 w, f32x4& v0, f32x4& v1) { v0 = (f32x4){bf_lo(w.x), bf_hi(w.x), bf_lo(w.y), bf_hi(w.y)}; v1 = (f32x4){bf_lo(w.z), bf_hi(w.z), bf_lo(w.w), bf_hi(w.w)}; }

struct EpiProj {
    static constexpr bool PERM = true, AFTER_DRAIN = false, KHOOK = false;
    bf16_t *U, *SZ, *MZ, *XBC, *G1, *G2;
    template <int ACT> __device__ __forceinline__ void store_tile(const f32x4 (&acc)[2][2][4][2], bf16_t* base, size_t rs, size_t bs, int row0) const {
#pragma unroll
        for (int ai = 0; ai < 2; ++ai)
#pragma unroll
            for (int m = 0; m < 4; ++m) { bf16_t* rowp = base + (size_t)(row0 + ai * HALF + m * 16) * rs;
#pragma unroll
                for (int bj = 0; bj < 2; ++bj) { f32x4 v0 = acc[ai][bj][m][0], v1 = acc[ai][bj][m][1];
#pragma unroll
                    for (int e = 0; e < 4; ++e) { v0[e] = act_f<ACT>(v0[e]); v1[e] = act_f<ACT>(v1[e]); }
                    __builtin_nontemporal_store(pack8(v0, v1), (u32x4*)(rowp + bj * bs)); } }
    }
    __device__ __forceinline__ void operator()(const f32x4 (&acc)[2][2][4][2], const Unit& u, int wr, int wc, int fr, int fq) const {
        EPI_MFMA_SETTLE();
        const int pn = u.pn, row0 = u.pm * BM + wr * 64 + fr, cl = wc * 32 + 8 * fq;
        if (pn < 16) {
            const int col = pn * BM + cl; store_tile<0>(acc, U + (size_t)(col >> 4) * (8192 * 16) + (col & 15), 16, (size_t)8 * 8192 * 16, row0);
        } else if (pn < 32) {
            store_tile<1>(acc, SZ + (pn - 16) * BM + cl, 4096, HALF, row0);
        } else if (pn < 64) {
            store_tile<1>(acc, MZ + (pn - 32) * BM + cl, 8192, HALF, row0);
        } else if (pn < 104) {
            store_tile<0>(acc, XBC + (pn - 64) * BM + cl, 10240, HALF, row0);
        } else if (pn < 120) {
            store_tile<2>(acc, G1 + (pn - 104) * BM + cl, 4096, HALF, row0);
        } else {
            store_tile<2>(acc, G2 + (pn - 120) * BM + cl, 4096, HALF, row0);
        }
    }
};
struct EpiDTP {
    static constexpr bool PERM = true, AFTER_DRAIN = false, KHOOK = false;
    float* DTP;
    __device__ __forceinline__ void operator()(const f32x4 (&acc)[2][2][4][2], const Unit& u, int wr, int wc, int fr, int fq) const {
        const int row0 = u.pm * BM + wr * 64 + fr, cl = wc * 32 + 8 * fq;
#pragma unroll
        for (int ai = 0; ai < 2; ++ai)
#pragma unroll
            for (int m = 0; m < 4; ++m) { float* rowp = DTP + ((size_t)u.pn * 8192 + row0 + ai * HALF + m * 16) * 128 + cl;
                *(f32x4*)(rowp) = acc[ai][0][m][0]; *(f32x4*)(rowp + 4) = acc[ai][0][m][1]; }
    }
};
struct EpiGlu {
    static constexpr bool PERM = true, AFTER_DRAIN = false, KHOOK = false;
    const bf16_t* SZ; const float* bias; bf16_t* O;
    __device__ __forceinline__ void operator()(const f32x4 (&acc)[2][2][4][2], const Unit& u, int wr, int wc, int fr, int fq) const {
        EPI_MFMA_SETTLE();
        const int row0 = u.pm * BM + wr * 64 + fr, j0 = u.pn * HALF + wc * 32 + 8 * fq;
        const f32x4 ba0 = *(const f32x4*)(bias + j0), ba1 = *(const f32x4*)(bias + j0 + 4), bb0 = *(const f32x4*)(bias + 4096 + j0), bb1 = *(const f32x4*)(bias + 4096 + j0 + 4);
        u32x4 zr[8];
#pragma unroll
        for (int i = 0; i < 8; ++i) zr[i] = *(const u32x4*)(SZ + (size_t)(row0 + (i >> 2) * HALF + (i & 3) * 16) * 4096 + j0);
#pragma unroll
        for (int ai = 0; ai < 2; ++ai)
#pragma unroll
            for (int m = 0; m < 4; ++m) { const size_t off = (size_t)(row0 + ai * HALF + m * 16) * 4096 + j0;
                f32x4 z0, z1; unpack8(zr[ai * 4 + m], z0, z1);
                f32x4 a0 = acc[ai][0][m][0] + ba0, a1 = acc[ai][0][m][1] + ba1, b0 = acc[ai][1][m][0] + bb0, b1 = acc[ai][1][m][1] + bb1;
#pragma unroll
                for (int e = 0; e < 4; ++e) { a0[e] = a0[e] * sigmoid_f(b0[e]) * z0[e]; a1[e] = a1[e] * sigmoid_f(b1[e]) * z1[e]; }
                *(u32x4*)(O + off) = pack8(a0, a1); }
    }
};
struct EpiBrS {
    static constexpr bool PERM = true, AFTER_DRAIN = false, KHOOK = false;
    const bf16_t* G1; bf16_t* T1;
    __device__ __forceinline__ void operator()(const f32x4 (&acc)[2][2][4][2], const Unit& u, int wr, int wc, int fr, int fq) const {
        EPI_MFMA_SETTLE();
        const int row0 = u.pm * BM + wr * 64 + fr, c0 = u.pn * BM + wc * 32 + 8 * fq;
#pragma unroll
        for (int ai = 0; ai < 2; ++ai) { u32x4 gr[8];
#pragma unroll
            for (int i = 0; i < 8; ++i) gr[i] = *(const u32x4*)(G1 + (size_t)(row0 + ai * HALF + (i >> 1) * 16) * 4096 + c0 + (i & 1) * HALF);
#pragma unroll
            for (int m = 0; m < 4; ++m)
#pragma unroll
                for (int bj = 0; bj < 2; ++bj) { const size_t off = (size_t)(row0 + ai * HALF + m * 16) * 4096 + c0 + bj * HALF;
                    f32x4 g0, g1; unpack8(gr[m * 2 + bj], g0, g1);
                    *(u32x4*)(T1 + off) = pack8(acc[ai][bj][m][0] * g0, acc[ai][bj][m][1] * g1); } }
    }
};
struct EpiBrM {
    static constexpr bool PERM = true, AFTER_DRAIN = false, KHOOK = true;
    const bf16_t* G2; const bf16_t* T1; bf16_t* O; const float* RT;
    __device__ __forceinline__ void unit_begin(const Unit& u, PG8_LAS unsigned char* tbl, int tid) const {
        const f32x4 v = *(const f32x4*)(RT + (size_t)u.pm * BM * 8 + 4 * tid); *(PG8_LAS f32x4*)(tbl + 16 * tid) = v;
    }
    __device__ __forceinline__ void khook(f32x4 (&acc)[2][2][4][2], const PG8_LAS unsigned char* tbl, int g, int wr, int fr) const {
#pragma unroll
        for (int ai = 0; ai < 2; ++ai)
#pragma unroll
            for (int m = 0; m < 4; ++m) { const float f = *(const PG8_LAS float*)(tbl + ((ai * HALF + wr * 64 + m * 16 + fr) * 8 + g) * 4);
#pragma unroll
                for (int bj = 0; bj < 2; ++bj)
#pragma unroll
                    for (int n = 0; n < 2; ++n) acc[ai][bj][m][n] = acc[ai][bj][m][n] * f; }
    }
    __device__ __forceinline__ void epi(const f32x4 (&acc)[2][2][4][2], const Unit& u, int wr, int wc, int fr, int fq, const PG8_LAS unsigned char* tbl) const {
        const int row0 = u.pm * BM + wr * 64 + fr, c0 = u.pn * BM + wc * 32 + 8 * fq;
#pragma unroll
        for (int ai = 0; ai < 2; ++ai) { u32x4 gr[8], tr[8];
#pragma unroll
            for (int i = 0; i < 8; ++i) { const size_t off = (size_t)(row0 + ai * HALF + (i >> 1) * 16) * 4096 + c0 + (i & 1) * HALF; gr[i] = *(const u32x4*)(G2 + off); tr[i] = *(const u32x4*)(T1 + off); }
#pragma unroll
            for (int m = 0; m < 4; ++m) { const float f = *(const PG8_LAS float*)(tbl + ((ai * HALF + wr * 64 + m * 16 + fr) * 8 + 7) * 4);
#pragma unroll
                for (int bj = 0; bj < 2; ++bj) { const size_t off = (size_t)(row0 + ai * HALF + m * 16) * 4096 + c0 + bj * HALF;
                    f32x4 g0, g1; unpack8(gr[m * 2 + bj], g0, g1);
                    f32x4 t0, t1; unpack8(tr[m * 2 + bj], t0, t1);
                    *(u32x4*)(O + off) = pack8(t0 + acc[ai][bj][m][0] * (g0 * f), t1 + acc[ai][bj][m][1] * (g1 * f)); } } }
    }
};
struct EpiOut {
    static constexpr bool PERM = true, AFTER_DRAIN = false, KHOOK = false;
    const float* X; const float* gate; bf16_t* O; float* SS;
    __device__ __forceinline__ void operator()(const f32x4 (&acc)[2][2][4][2], const Unit& u, int wr, int wc, int fr, int fq) const {
        EPI_MFMA_SETTLE();
        const int row0 = u.pm * BM + wr * 64 + fr, c0 = u.pn * BM + wc * 32 + 8 * fq;
        f32x4 gv[2][2];
#pragma unroll
        for (int bj = 0; bj < 2; ++bj) { gv[bj][0] = *(const f32x4*)(gate + c0 + bj * HALF); gv[bj][1] = *(const f32x4*)(gate + c0 + bj * HALF + 4); }
#pragma unroll
        for (int ai = 0; ai < 2; ++ai)
#pragma unroll
            for (int mh = 0; mh < 2; ++mh) { f32x4 xr[8];
#pragma unroll
                for (int i = 0; i < 8; ++i) xr[i] = *(const f32x4*)(X + (size_t)(row0 + ai * HALF + (2 * mh + (i >> 2)) * 16) * 4096 + c0 + ((i >> 1) & 1) * HALF + 4 * (i & 1));
#pragma unroll
                for (int mm = 0; mm < 2; ++mm) { const int m = 2 * mh + mm, row = row0 + ai * HALF + m * 16; float s = 0.f;
#pragma unroll
                    for (int bj = 0; bj < 2; ++bj) { const size_t off = (size_t)row * 4096 + c0 + bj * HALF;
                        const f32x4 o0 = xr[mm * 4 + bj * 2] + acc[ai][bj][m][0] * gv[bj][0], o1 = xr[mm * 4 + bj * 2 + 1] + acc[ai][bj][m][1] * gv[bj][1];
                        *(u32x4*)(O + off) = pack8(o0, o1);
                        s += (o0[0] * o0[0] + o0[1] * o0[1]) + (o0[2] * o0[2] + o0[3] * o0[3]) + (o1[0] * o1[0] + o1[1] * o1[1]) + (o1[2] * o1[2] + o1[3] * o1[3]); }
                    s += __shfl_xor(s, 16); s += __shfl_xor(s, 32);
                    if (fq == 0) SS[(size_t)row * 64 + u.pn * 4 + wc] = s; } }
    }
};
template <class Epi, class Sched, bool ALIGN_EPI = false, bool SP2 = false, bool SPLITK = false>
__device__ __forceinline__ void gemm_phase(PG8_LAS unsigned char* lds, const Gemm g, const Sched& S, const Epi& E) {
    const int tid = threadIdx.x, wid = __builtin_amdgcn_readfirstlane(tid >> 6), lane = tid & 63, wr = wid >> 2, wc = wid & 3, fr = lane & 15, fq = lane >> 4;
    const int K = g.K, nt = K / BK, LD = g.ld;
    unsigned voffA[2], voffB[2];
#pragma unroll
    for (int i = 0; i < 2; ++i) { int R, C; stage_rc(tid * 16 + i * 8192, R, C); const int Rb = Epi::PERM ? ((R & ~31) + perm32(R & 31)) : R;
        voffA[i] = (unsigned)(R * LD + C) * 2u; voffB[i] = (unsigned)(Rb * LD + C) * 2u; }
    const size_t kstep = (size_t)(BK * 2);
    const size_t hstep = (size_t)HALF * LD * 2;
    const size_t tstep = 2 * hstep;
    const unsigned ldsw = (unsigned)wid * 1024u;
    const int aoff = lds_byte(wr * 64 + fr, fq * 8), boff = lds_byte(wc * 32 + fr, fq * 8);
#define PG8_SA(b, h) (((b) * 2 + (h)) * HTB)
#define PG8_SB(b, h) ((4 + (b) * 2 + (h)) * HTB)
#define PG8_STAGE(bufoff, gbase, voff) do { _Pragma("unroll") for (int _i = 0; _i < 2; ++_i) \
        __builtin_amdgcn_global_load_lds((const unsigned*)((const char*)(gbase) + (voff)[_i]), (PG8_LAS unsigned*)(lds + (bufoff) + ldsw + _i * 8192), 16, 0, 0); } while (0)
#define PG8_LDA(dst, b, h) do { _Pragma("unroll") for (int m = 0; m < 4; ++m) _Pragma("unroll") for (int k = 0; k < 2; ++k) dst[m][k] = *(const PG8_LAS bf16x8*)(lds + PG8_SA(b, h) + aoff + m * 2048 + k * 1024); } while (0)
#define PG8_LDB(dst, b, h) do { _Pragma("unroll") for (int n = 0; n < 2; ++n) _Pragma("unroll") for (int k = 0; k < 2; ++k) dst[n][k] = *(const PG8_LAS bf16x8*)(lds + PG8_SB(b, h) + boff + n * 2048 + k * 1024); } while (0)
#define PG8_MMA(ai, bj, At, Bt) do { __builtin_amdgcn_s_setprio(1); _Pragma("unroll") for (int m = 0; m < 4; ++m) _Pragma("unroll") for (int n = 0; n < 2; ++n) _Pragma("unroll") for (int k = 0; k < 2; ++k) \
        acc[ai][bj][m][n] = __builtin_amdgcn_mfma_f32_16x16x32_bf16(Bt[n][k], At[m][k], acc[ai][bj][m][n], 0, 0, 0); __builtin_amdgcn_s_setprio(0); } while (0)
#define PG8_WAIT_V(n) asm volatile("s_waitcnt vmcnt(" #n ")" ::: "memory")
#define PG8_WAIT_L(n) asm volatile("s_waitcnt lgkmcnt(" #n ")" ::: "memory")
#define PG8_BAR __builtin_amdgcn_s_barrier()
#define PG8_SCHED __builtin_amdgcn_sched_barrier(0)
    Unit cur, nxt; int ui = 0;
    if (!S.next(0, cur)) return;
    f32x4 acc[2][2][4][2];
#pragma unroll
    for (int a = 0; a < 2; ++a)
#pragma unroll
        for (int b = 0; b < 2; ++b)
#pragma unroll
            for (int m = 0; m < 4; ++m)
#pragma unroll
                for (int n = 0; n < 2; ++n) acc[a][b][m][n] = (f32x4){0.f, 0.f, 0.f, 0.f};
    bf16x8 At[4][2], B0[2][2], B1[2][2];
    const char* cA = (const char*)g.A + (size_t)cur.pm * tstep + (SPLITK ? (size_t)cur.pn * K * 2 : (size_t)0); const char* cB = (const char*)g.Bt + (SPLITK ? (size_t)cur.pn * K * 2 : (size_t)cur.pn * tstep);
    S.a_ready(cur);
    if constexpr (SP2) {
        PG8_STAGE(PG8_SB(0, 0), cB, voffB); PG8_STAGE(PG8_SB(0, 1), cB + hstep, voffB); PG8_STAGE(PG8_SA(0, 0), cA, voffA); PG8_STAGE(PG8_SA(0, 1), cA + hstep, voffA);
        if (wr == 1) PG8_BAR;
        PG8_WAIT_V(2); PG8_BAR;
        PG8_STAGE(PG8_SB(1, 0), cB + kstep, voffB); PG8_STAGE(PG8_SA(1, 0), cA + kstep, voffA); PG8_STAGE(PG8_SB(1, 1), cB + hstep + kstep, voffB);
        PG8_WAIT_V(6); PG8_BAR;
    } else {
        PG8_STAGE(PG8_SB(0, 0), cB, voffB); PG8_STAGE(PG8_SA(0, 0), cA, voffA); PG8_STAGE(PG8_SB(0, 1), cB + hstep, voffB); PG8_STAGE(PG8_SA(0, 1), cA + hstep, voffA);
        if (wr == 1) PG8_BAR;
        PG8_WAIT_V(4); PG8_BAR;
        PG8_STAGE(PG8_SB(1, 0), cB + kstep, voffB); PG8_STAGE(PG8_SA(1, 0), cA + kstep, voffA); PG8_STAGE(PG8_SB(1, 1), cB + hstep + kstep, voffB);
        PG8_WAIT_V(6); PG8_BAR;
    }
    for (;;) {
        const bool has_next = S.next(ui + 1, nxt);
        if constexpr (Epi::KHOOK) E.unit_begin(cur, lds + STAGE_BYTES + (ui & 1) * 8192, tid);
        const char* nA = has_next ? (const char*)g.A + (size_t)nxt.pm * tstep + (SPLITK ? (size_t)nxt.pn * K * 2 : (size_t)0) : cA; const char* nB = has_next ? (const char*)g.Bt + (SPLITK ? (size_t)nxt.pn * K * 2 : (size_t)nxt.pn * tstep) : cB;
        for (int t = 0; t < nt; t += 2) {
            const bool last = (t == nt - 2);
            const char* a1 = cA + (size_t)(t + 1) * kstep;
            const char* a2 = last ? nA : cA + (size_t)(t + 2) * kstep; const char* b2 = last ? nB : cB + (size_t)(t + 2) * kstep;
            const char* a3 = a2 + kstep; const char* b3 = b2 + kstep;
            if (last && has_next) S.a_ready(nxt);
            if constexpr (SP2) {
            PG8_LDB(B0, 0, 0); PG8_LDB(B1, 0, 1); PG8_SCHED; PG8_LDA(At, 0, 0); PG8_STAGE(PG8_SA(1, 1), a1 + hstep, voffA);
            PG8_WAIT_V(8); PG8_WAIT_L(0); PG8_BAR; PG8_MMA(0, 0, At, B0); PG8_MMA(0, 1, At, B1); PG8_BAR; PG8_SCHED;
            PG8_LDA(At, 0, 1); PG8_STAGE(PG8_SB(0, 0), b2, voffB); PG8_STAGE(PG8_SB(0, 1), b2 + hstep, voffB); PG8_STAGE(PG8_SA(0, 0), a2, voffA);
            PG8_WAIT_V(8); PG8_WAIT_L(0); PG8_BAR; PG8_MMA(1, 0, At, B0); PG8_MMA(1, 1, At, B1); PG8_BAR; PG8_SCHED;
            PG8_LDB(B0, 1, 0); PG8_LDB(B1, 1, 1); PG8_SCHED; PG8_LDA(At, 1, 0); PG8_STAGE(PG8_SA(0, 1), a2 + hstep, voffA);
            PG8_WAIT_V(8); PG8_WAIT_L(0); PG8_BAR; PG8_MMA(0, 0, At, B0); PG8_MMA(0, 1, At, B1); PG8_BAR; PG8_SCHED;
            PG8_LDA(At, 1, 1); PG8_STAGE(PG8_SB(1, 0), b3, voffB); PG8_STAGE(PG8_SB(1, 1), b3 + hstep, voffB); PG8_STAGE(PG8_SA(1, 0), a3, voffA);
            PG8_WAIT_V(8); PG8_WAIT_L(0); PG8_BAR; PG8_MMA(1, 0, At, B0); PG8_MMA(1, 1, At, B1); PG8_BAR; PG8_SCHED;
            if constexpr (Epi::KHOOK) { if ((t & 15) == 14 && !last) { E.khook(acc, lds + STAGE_BYTES + (ui & 1) * 8192, t >> 4, wr, fr); } }
            } else {
            PG8_LDB(B0, 0, 0); PG8_SCHED; PG8_LDA(At, 0, 0); PG8_STAGE(PG8_SA(1, 1), a1 + hstep, voffA);
            PG8_WAIT_L(8); PG8_BAR; PG8_WAIT_L(0); PG8_MMA(0, 0, At, B0); PG8_BAR; PG8_SCHED;
            PG8_LDB(B1, 0, 1); PG8_STAGE(PG8_SB(0, 0), b2, voffB);
            PG8_BAR; PG8_WAIT_L(0); PG8_MMA(0, 1, At, B1); PG8_BAR;
            PG8_LDA(At, 0, 1); PG8_STAGE(PG8_SA(0, 0), a2, voffA);
            PG8_BAR; PG8_WAIT_L(0); PG8_MMA(1, 0, At, B0); PG8_BAR; PG8_SCHED;
            PG8_STAGE(PG8_SB(0, 1), b2 + hstep, voffB);
            PG8_WAIT_V(6); PG8_BAR; PG8_MMA(1, 1, At, B1); PG8_BAR;
            PG8_LDB(B0, 1, 0); PG8_SCHED; PG8_LDA(At, 1, 0); PG8_STAGE(PG8_SA(0, 1), a2 + hstep, voffA);
            PG8_WAIT_L(8); PG8_BAR; PG8_WAIT_L(0); PG8_MMA(0, 0, At, B0); PG8_BAR; PG8_SCHED;
            PG8_LDB(B1, 1, 1); PG8_STAGE(PG8_SB(1, 0), b3, voffB);
            PG8_BAR; PG8_WAIT_L(0); PG8_MMA(0, 1, At, B1); PG8_BAR;
            PG8_LDA(At, 1, 1); PG8_STAGE(PG8_SA(1, 0), a3, voffA);
            PG8_BAR; PG8_WAIT_L(0); PG8_MMA(1, 0, At, B0); PG8_BAR; PG8_SCHED;
            PG8_STAGE(PG8_SB(1, 1), b3 + hstep, voffB);
            PG8_WAIT_V(6); PG8_BAR; PG8_MMA(1, 1, At, B1); PG8_BAR;
            }
        }
        if constexpr (ALIGN_EPI) { if (wr == 0) PG8_BAR; }
        if constexpr (!Epi::AFTER_DRAIN) { if constexpr (Epi::KHOOK) E.epi(acc, cur, wr, wc, fr, fq, lds + STAGE_BYTES + (ui & 1) * 8192); else E(acc, cur, wr, wc, fr, fq); S.done(cur); }
        if (!has_next) break;
#pragma unroll
        for (int a = 0; a < 2; ++a)
#pragma unroll
            for (int b = 0; b < 2; ++b)
#pragma unroll
                for (int m = 0; m < 4; ++m)
#pragma unroll
                    for (int n = 0; n < 2; ++n) acc[a][b][m][n] = (f32x4){0.f, 0.f, 0.f, 0.f};
        cur = nxt; cA = nA; cB = nB; ++ui;
        if constexpr (ALIGN_EPI) { if (wr == 1) PG8_BAR; }
    }
    PG8_WAIT_V(0);
    if constexpr (!ALIGN_EPI) { if (wr == 0) PG8_BAR; }
    PG8_BAR;
    if constexpr (Epi::AFTER_DRAIN) { E.fused(acc, cur, wr, wc, fr, fq, lds, wid, lane); S.done(cur); }
#undef PG8_SA
#undef PG8_SB
#undef PG8_STAGE
#undef PG8_LDA
#undef PG8_LDB
#undef PG8_MMA
#undef PG8_WAIT_V
#undef PG8_WAIT_L
#undef PG8_BAR
#undef PG8_SCHED
}
}
#ifndef PG8_SP2
#define PG8_SP2 true
#endif
#ifndef PG8_ALIGN
#define PG8_ALIGN true
#endif
constexpr int NWAVES = 8;
#ifndef MK_N_LAUNCHES
#define MK_N_LAUNCHES 1
#endif
constexpr int NPH = 11;
constexpr int N_LAUNCHES = MK_N_LAUNCHES;

constexpr int M = 8192, D = 4096;
constexpr int S5G = 256, S5P = 16, S5N = 64;
constexpr int DI = 8192, NH = 128, HD = 64, NG = 8, NS = 128, CONVD = 10240;
constexpr int IN_COLS = 34944, NPROJ = 35072, NMAIN = 34816;
constexpr float EPS = 1e-6f;

constexpr size_t MiB = 1u << 20;
constexpr size_t WS_CTL = 0, CTL_ZERO_BYTES = 1 * MiB;
constexpr size_t WS_MODP = 1 * MiB;
constexpr size_t WS_GATE = 1 * MiB + 512 * 1024;
constexpr size_t WS_SS = 2 * MiB;
constexpr size_t WS_S5C = 2 * MiB;
constexpr size_t WS_DT = 4 * MiB;
constexpr size_t WS_WGLU = 8 * MiB, WS_WBRS = 72 * MiB, WS_WBRM = 104 * MiB, WS_WOUT = 168 * MiB;
constexpr size_t WS_U = 200 * MiB;
constexpr size_t WS_SZ = 264 * MiB;
constexpr size_t WS_MZ = 328 * MiB;
constexpr size_t WS_XBC = 456 * MiB;
constexpr size_t WS_G1 = 616 * MiB, WS_G2 = 680 * MiB;
constexpr size_t WS_WIN = 744 * MiB;
constexpr size_t WS_YSSD = 744 * MiB, WS_YM2 = 872 * MiB;
constexpr size_t WS_H = 1018 * MiB;
constexpr size_t WS_YS5 = 1018 * MiB;
constexpr size_t WS_XC = 1082 * MiB;
constexpr size_t WS_DTS = 1242 * MiB;
constexpr size_t WS_END = 1246 * MiB;
constexpr size_t WS_YS5G = WS_U, WS_MERGED = WS_SZ, WS_T1 = WS_MZ;
constexpr size_t WS_X2 = WS_G1;
static_assert(WS_WIN + (size_t)NPROJ * D * 2 <= WS_H && WS_H + (size_t)M * D * 2 <= WS_XC && WS_XC + (size_t)M * CONVD * 2 <= WS_DTS, "d_ws map");
constexpr int CW_BAR = 4096;

constexpr int RING_OFF = 0, RING_BYTES = 131072;
constexpr int LDSCTL_OFF = 151552, MISC_OFF = LDSCTL_OFF + 320;
constexpr int LDS_BYTES = 155648;
static_assert(MISC_OFF + 128 <= LDS_BYTES, "LDS map");

#define GAS __attribute__((address_space(1)))
#define LAS __attribute__((address_space(3)))
typedef unsigned short bf16;
typedef unsigned v4u __attribute__((ext_vector_type(4)));
typedef unsigned v2u __attribute__((ext_vector_type(2)));
typedef float f32x4 __attribute__((ext_vector_type(4)));
typedef short bf16x8 __attribute__((ext_vector_type(8)));
typedef GAS unsigned gu32;
#define RLX_AGENT __ATOMIC_RELAXED, __HIP_MEMORY_SCOPE_AGENT
#define LDS_WAIT() asm volatile("s_waitcnt lgkmcnt(0)" ::: "memory")
#define VM_WAIT() asm volatile("s_waitcnt vmcnt(0)" ::: "memory")
typedef float f32x2c __attribute__((ext_vector_type(2)));
typedef __bf16 bf16x2c __attribute__((ext_vector_type(2)));
__device__ __forceinline__ unsigned pk2(float lo, float hi) { return __builtin_bit_cast(unsigned, __builtin_convertvector(((f32x2c){lo, hi}), bf16x2c)); }
__device__ __forceinline__ unsigned f2bf(float f) { return pk2(f, 0.f) & 0xffffu; }
__device__ __forceinline__ float bf2f(bf16 h) { return __builtin_bit_cast(float, (unsigned)h << 16); }
using pg8::bf_lo; using pg8::bf_hi;
#define XB_TMO      128
#define XB_XCNT(j)  (256  + 64 * (j))
#define XB_XSUB(j)  (1280 + 64 * (j))
#define XB_XGEN(j)  (2304 + 64 * (j))
#define XB_TOP      3328
#define XB_TOPGEN   3392
#define XCD_BAR_WORDS 3456
#define XB_SPIN_CAP (1u << 18)

__device__ __forceinline__ unsigned xb_ld(unsigned* p)              { return __hip_atomic_load(p, __ATOMIC_RELAXED, __HIP_MEMORY_SCOPE_AGENT); }
__device__ __forceinline__ unsigned xb_add(unsigned* p, unsigned v) { return __hip_atomic_fetch_add(p, v, __ATOMIC_RELAXED, __HIP_MEMORY_SCOPE_AGENT); }
__device__ __forceinline__ unsigned xb_xcc_id() { return (unsigned)__builtin_amdgcn_s_getreg((3 << 11) | 20) & 0xFu; }
#define XB_SPIN(cond, bar) do { unsigned _sp = 0; while (cond) { __builtin_amdgcn_s_sleep(1); \
    if ((++_sp & 255u) == 0u) { if (xb_ld(&(bar)[XB_TMO])) break; if (_sp > XB_SPIN_CAP) { atomicAdd(&(bar)[XB_TMO], 1u); break; } } } } while (0)

struct XcdBarrier {
    unsigned* bar; unsigned x;
    volatile LAS unsigned* st;
};

__device__ __forceinline__ XcdBarrier xcd_barrier_post(unsigned* bar, volatile LAS unsigned* st) {
    XcdBarrier b; b.bar = bar; b.x = xb_xcc_id(); b.st = st;
    if (threadIdx.x == 0) (void)xb_add(&bar[XB_XCNT(b.x)], 1u);
    return b;
}
__device__ __forceinline__ void xcd_barrier_complete(unsigned* bar, unsigned x, unsigned& nloc, unsigned& nx) {
    const unsigned G = gridDim.x * gridDim.y * gridDim.z;
    unsigned sum, cnt, mine, sp = 0u;
    for (;;) {
        sum = 0u; cnt = 0u; mine = 0u;
#pragma unroll
        for (unsigned j = 0; j < 16; ++j) { const unsigned c = xb_ld(&bar[XB_XCNT(j)]); sum += c; cnt += (c > 0u) ? 1u : 0u; mine = (j == x) ? c : mine; }
        if (sum == G) break;
        __builtin_amdgcn_s_sleep(1);
        if ((++sp & 255u) == 0u) { if (xb_ld(&bar[XB_TMO])) break; if (sp > XB_SPIN_CAP) { atomicAdd(&bar[XB_TMO], 1u); break; } }
    }
    nloc = mine > 0u ? mine : 1u; nx = cnt > 0u ? cnt : 1u;
}

__device__ __forceinline__ void xcd_barrier(const XcdBarrier& b) {
    asm volatile("s_waitcnt vmcnt(0)" ::: "memory");
    __syncthreads();
    if (threadIdx.x == 0) {
        unsigned* bar = b.bar;
        __builtin_amdgcn_s_waitcnt(0);
        unsigned nloc = b.st[0], nx = b.st[1];
        if (nloc == 0u) { xcd_barrier_complete(bar, b.x, nloc, nx); b.st[0] = nloc; b.st[1] = nx; }
        const unsigned old = xb_add(&bar[XB_XSUB(b.x)], 1u);
        const unsigned gen = old / nloc;
        if (old + 1u == (gen + 1u) * nloc) {
            __builtin_amdgcn_fence(__ATOMIC_RELEASE, "agent");
            asm volatile("s_waitcnt vmcnt(0)" ::: "memory");
            const unsigned og = xb_add(&bar[XB_TOP], 1u);
            const unsigned tg = og / nx;
            if (og + 1u == (tg + 1u) * nx) xb_add(&bar[XB_TOPGEN], 1u);
            else XB_SPIN(xb_ld(&bar[XB_TOPGEN]) == tg, bar);
            __builtin_amdgcn_fence(__ATOMIC_ACQUIRE, "agent");
            xb_add(&bar[XB_XGEN(b.x)], 1u);
            asm volatile("s_waitcnt vmcnt(0)" ::: "memory");
        } else {
            XB_SPIN(xb_ld(&bar[XB_XGEN(b.x)]) == gen, bar);
            __builtin_amdgcn_fence(__ATOMIC_ACQUIRE, "agent");
            asm volatile("s_waitcnt vmcnt(0)" ::: "memory");
        }
    }
    __syncthreads();
}
__device__ __forceinline__ float wave_sum(float v) {
#pragma unroll
    for (int o = 1; o < 64; o <<= 1) v += __shfl_xor(v, o);
    return v;
}
constexpr int TR_PITCH = 34, TR_BYTES = 64 * TR_PITCH * 2;
__device__ __forceinline__ void p0_transpose_item(const float* W, int K, int N, bf16* WT, int src_n0, int dst_n0, int k0, LAS bf16* scr, int lane, const float* kscale = nullptr) {
    if (src_n0 >= 0) {
        f32x4 v[8];
#pragma unroll
        for (int i = 0; i < 8; ++i) v[i] = __builtin_nontemporal_load((const GAS f32x4*)(W + (size_t)(k0 + 8 * i + (lane >> 3)) * N + src_n0 + 4 * (lane & 7)));
        if (kscale) {
#pragma unroll
            for (int i = 0; i < 8; ++i) v[i] = v[i] * kscale[k0 + 8 * i + (lane >> 3)]; }
#pragma unroll
        for (int i = 0; i < 8; ++i) { LAS unsigned* d = (LAS unsigned*)(scr + (8 * i + (lane >> 3)) * TR_PITCH + 4 * (lane & 7)); d[0] = pk2(v[i].x, v[i].y); d[1] = pk2(v[i].z, v[i].w); }
    } else {
#pragma unroll
        for (int i = 0; i < 8; ++i) { LAS unsigned* d = (LAS unsigned*)(scr + (8 * i + (lane >> 3)) * TR_PITCH + 4 * (lane & 7)); d[0] = 0u; d[1] = 0u; }
    }
    LDS_WAIT(); asm volatile("" ::: "memory");
    const int c = lane & 7;
#pragma unroll
    for (int j = 0; j < 4; ++j) { const int n = (lane >> 3) + 8 * j; const LAS bf16* s = scr + (8 * c) * TR_PITCH + n;
        v4u o; o.x = (unsigned)s[0] | ((unsigned)s[TR_PITCH] << 16); o.y = (unsigned)s[2 * TR_PITCH] | ((unsigned)s[3 * TR_PITCH] << 16);
        o.z = (unsigned)s[4 * TR_PITCH] | ((unsigned)s[5 * TR_PITCH] << 16); o.w = (unsigned)s[6 * TR_PITCH] | ((unsigned)s[7 * TR_PITCH] << 16);
        *(GAS v4u*)(WT + (size_t)(dst_n0 + n) * K + k0 + 8 * c) = o; }
    LDS_WAIT(); asm volatile("" ::: "memory");
}
__device__ __forceinline__ int win_src_col(int d) { return d < 26624 ? d : (d < 34816 ? d + 128 : (d < 34944 ? d - 34816 + 26624 : -1)); }
__device__ __forceinline__ int wglu_src_col(int d) { const int pn = d >> 8, r = d & 255; return r < 128 ? 128 * pn + r : 4096 + 128 * pn + (r - 128); }

struct Args {
    const float *x, *c, *w_ada, *b_ada, *norm_g, *w_in, *lam_re, *lam_im, *log_step, *b_re, *b_im, *c_re, *c_im, *s5_d, *w_glu, *b_glu,
                *conv_w, *conv_b, *dt_bias, *a_log, *m2_d, *m2_norm_g, *w_br_s5, *w_br_m2, *w_out, *final_g;
    float* out; unsigned char* ws; int ph_lo, ph_hi, sub, pad;
};

__device__ __forceinline__ void p0_gemv(const float* c, const float* W, float* MODP, LAS float* red, int wg, int G, int tid) {
    const int cg = tid & 31, rg = tid >> 5;
    for (int it = wg; it < 768; it += G) {
        const int cb = it % 96, ks = it / 96;
        const float* wp = W + (size_t)(ks * 512 + rg) * 12288 + cb * 128 + cg * 4;
        const float* cp = c + ks * 512 + rg;
        f32x4 acc = (f32x4){0.f, 0.f, 0.f, 0.f};
#pragma unroll 8
        for (int i = 0; i < 32; ++i) { const f32x4 w = __builtin_nontemporal_load((const f32x4*)(wp + (size_t)i * 16 * 12288)); const float cv = cp[i * 16]; acc = acc + w * cv; }
        *(LAS f32x4*)(red + rg * 128 + cg * 4) = acc;
        __syncthreads();
        if (tid < 128) { float s = 0.f;
#pragma unroll
            for (int r = 0; r < 16; ++r) s += red[r * 128 + tid];
            MODP[ks * 12288 + cb * 128 + tid] = s; }
        __syncthreads();
    }
}
__device__ __forceinline__ void p0_weights_in(const Args& a, LAS bf16* scr, int gw, int NGW, int lane) {
    bf16* WIN = (bf16*)(a.ws + WS_WIN);
    constexpr int I_IN = (D / 64) * (NPROJ / 32);
    for (int r = gw; r < I_IN; r += NGW) { const int nblk = NPROJ / 32, kb = r / nblk, nb = r % nblk; p0_transpose_item(a.w_in, D, IN_COLS, WIN, win_src_col(32 * nb), 32 * nb, 64 * kb, scr, lane); }
}
constexpr int P3_NCONV = 16 * 512, P3_NWITEMS = (D / 64) * (8192 / 32) + 2 * (D / 64) * (D / 32) + (DI / 64) * (D / 32);
__device__ __forceinline__ void p3_weight_item(const Args& a, LAS bf16* scr, int it, int lane) {
    bf16* WGLU = (bf16*)(a.ws + WS_WGLU); bf16* WBRS = (bf16*)(a.ws + WS_WBRS); bf16* WBRM = (bf16*)(a.ws + WS_WBRM); bf16* WOUT = (bf16*)(a.ws + WS_WOUT);
    constexpr int I_GLU = (D / 64) * (8192 / 32), I_BRS = (D / 64) * (D / 32), I_BRM = (DI / 64) * (D / 32), I_OUT = (D / 64) * (D / 32);
    static_assert(I_GLU + I_BRS + I_BRM + I_OUT == P3_NWITEMS, "item count");
    int r = it;
    if (r < I_GLU) { const int nblk = 8192 / 32, kb = r / nblk, nb = r % nblk; p0_transpose_item(a.w_glu, D, 8192, WGLU, wglu_src_col(32 * nb), 32 * nb, 64 * kb, scr, lane); return; } r -= I_GLU;
    if (r < I_BRS) { const int nblk = D / 32, kb = r / nblk, nb = r % nblk; p0_transpose_item(a.w_br_s5, D, D, WBRS, 32 * nb, 32 * nb, 64 * kb, scr, lane); return; } r -= I_BRS;
    if (r < I_BRM) { const int nblk = D / 32, kb = r / nblk, nb = r % nblk; p0_transpose_item(a.w_br_m2, DI, D, WBRM, 32 * nb, 32 * nb, 64 * kb, scr, lane, a.m2_norm_g); return; } r -= I_BRM;
    { const int nblk = D / 32, kb = r / nblk, nb = r % nblk; p0_transpose_item(a.w_out, D, D, WOUT, 32 * nb, 32 * nb, 64 * kb, scr, lane); }
}
__device__ __forceinline__ void p1_h(const Args& a, LAS float* ldsA, LAS float* ldsB, int gw, int NGW, int tid, int lane) {
    const float* MODP = (const float*)(a.ws + WS_MODP); float* GATE = (float*)(a.ws + WS_GATE); bf16* H = (bf16*)(a.ws + WS_H);
    for (int j = tid; j < 12288; j += NWAVES * 64) { float s = a.b_ada[j];
#pragma unroll
        for (int ks = 0; ks < 8; ++ks) s += MODP[ks * 12288 + j];
        if (j < 4096) ldsB[j] = s; else if (j < 8192) ldsA[j - 4096] = a.norm_g[j - 4096] * (1.0f + s); else if (blockIdx.x == 0) GATE[j - 8192] = s; }
    __syncthreads();
    for (int row = gw; row < M; row += NGW) {
        const GAS f32x4* xr = (const GAS f32x4*)(a.x + (size_t)row * D);
        f32x4 v[16]; float ss = 0.f;
#pragma unroll
        for (int j = 0; j < 8; ++j) { v[2 * j] = __builtin_nontemporal_load(xr + 128 * j + 2 * lane); v[2 * j + 1] = __builtin_nontemporal_load(xr + 128 * j + 2 * lane + 1); }
#pragma unroll
        for (int j = 0; j < 16; ++j) ss += (v[j].x * v[j].x + v[j].y * v[j].y) + (v[j].z * v[j].z + v[j].w * v[j].w);
        const float rstd = 1.0f / sqrtf(wave_sum(ss) * (1.0f / D) + EPS);
#pragma unroll
        for (int j = 0; j < 8; ++j) { const int col = 512 * j + 8 * lane;
            const f32x4 a0 = *(const LAS f32x4*)(ldsA + col), a1 = *(const LAS f32x4*)(ldsA + col + 4), b0 = *(const LAS f32x4*)(ldsB + col), b1 = *(const LAS f32x4*)(ldsB + col + 4);
            const f32x4 h0 = v[2 * j] * rstd * a0 + b0, h1 = v[2 * j + 1] * rstd * a1 + b1;
            v4u o; o.x = pk2(h0.x, h0.y); o.y = pk2(h0.z, h0.w); o.z = pk2(h1.x, h1.y); o.w = pk2(h1.z, h1.w);
            *(GAS v4u*)(H + (size_t)row * D + col) = o; }
    }
}
__device__ __forceinline__ float gelu_tanh(float x) { const float z = 0.7978845608028654f * (x + 0.044715f * x * x * x); return x * __builtin_amdgcn_rcpf(1.0f + __expf(-2.0f * z)); }
__device__ __forceinline__ float softplus_f(float x) { return fmaxf(x, 0.f) + log1pf(expf(-fabsf(x))); }
__device__ __forceinline__ void conv_task(const Args& a, int task, int lane) {
    const bf16* XBC = (const bf16*)(a.ws + WS_XBC); bf16* XC = (bf16*)(a.ws + WS_XC);
    {
        const int cb = task & 15, t0 = (task >> 4) * 16;
        const int c8 = (cb * 64 + lane) * 8;
        f32x4 w0[4], w1[4];
#pragma unroll
        for (int k = 0; k < 4; ++k) { w0[k] = *(const f32x4*)(a.conv_w + k * CONVD + c8); w1[k] = *(const f32x4*)(a.conv_w + k * CONVD + c8 + 4); }
        const f32x4 b0 = *(const f32x4*)(a.conv_b + c8), b1 = *(const f32x4*)(a.conv_b + c8 + 4);
        v4u raw[19];
#pragma unroll
        for (int i = 0; i < 19; ++i) { const int tt = t0 - 3 + i; raw[i] = (v4u){0u, 0u, 0u, 0u}; if (tt >= 0) raw[i] = __builtin_nontemporal_load((const GAS v4u*)(XBC + (size_t)tt * CONVD + c8)); }
        f32x4 r0[4], r1[4];
#pragma unroll
        for (int i = 0; i < 3; ++i) pg8::unpack8(raw[i], r0[i], r1[i]);
#pragma unroll
        for (int i = 3; i < 19; ++i) { pg8::unpack8(raw[i], r0[i & 3], r1[i & 3]);
            f32x4 acc0 = b0, acc1 = b1;
#pragma unroll
            for (int k = 0; k < 4; ++k) { acc0 = acc0 + r0[(i - 3 + k) & 3] * w0[k]; acc1 = acc1 + r1[(i - 3 + k) & 3] * w1[k]; }
#pragma unroll
            for (int e = 0; e < 4; ++e) { acc0[e] = pg8::silu_f(acc0[e]); acc1[e] = pg8::silu_f(acc1[e]); }
            v4u o; o.x = pk2(acc0.x, acc0.y); o.y = pk2(acc0.z, acc0.w); o.z = pk2(acc1.x, acc1.y); o.w = pk2(acc1.z, acc1.w);
            *(GAS v4u*)(XC + (size_t)(t0 + i - 3) * CONVD + c8) = o; }
    }
}
__device__ __forceinline__ void final_norm(const Args& a, int gw, int NGW, int lane) {
    const float* SS = (const float*)(a.ws + WS_SS); const bf16* X2 = (const bf16*)(a.ws + WS_X2);
    for (int row = gw; row < M; row += NGW) {
        const GAS v4u* xr = (const GAS v4u*)(X2 + (size_t)row * D); GAS f32x4* orow = (GAS f32x4*)(a.out + (size_t)row * D);
        v4u r[8];
#pragma unroll
        for (int j = 0; j < 8; ++j) r[j] = xr[64 * j + lane];
        const float rstd = 1.0f / sqrtf(wave_sum(SS[(size_t)row * 64 + lane]) * (1.0f / D) + EPS);
#pragma unroll
        for (int j = 0; j < 8; ++j) { const int col = 512 * j + 8 * lane; f32x4 v0, v1; pg8::unpack8(r[j], v0, v1);
            orow[128 * j + 2 * lane] = v0 * rstd * *(const f32x4*)(a.final_g + col); orow[128 * j + 2 * lane + 1] = v1 * rstd * *(const f32x4*)(a.final_g + col + 4); }
    }
}
constexpr int P3_CNT_OFF = 139264;
__device__ __forceinline__ void p3_stream_items(const Args& a, LAS unsigned char* L, LAS bf16* scr, int vcu, int G, int lane) {
    LAS unsigned* cnt = (LAS unsigned*)(L + P3_CNT_OFF);
    for (;;) {
        unsigned idx = 0u; if (lane == 0) idx = __hip_atomic_fetch_add(cnt, 1u, __ATOMIC_RELAXED, __HIP_MEMORY_SCOPE_WORKGROUP);
        idx = (unsigned)__builtin_amdgcn_readfirstlane((int)idx);
        const long id = (long)idx * G + vcu;
        if (id < P3_NCONV) conv_task(a, (int)id, lane);
        else if (id < P3_NCONV + P3_NWITEMS) p3_weight_item(a, scr, (int)(id - P3_NCONV), lane);
        else break;
    }
}
__device__ __forceinline__ void s5_consts(const Args& a, size_t gt, size_t NT) {
    float* S5C = (float*)(a.ws + WS_S5C);
    for (size_t idx = gt; idx < (size_t)S5G * S5N; idx += NT) {
        const int g = (int)(idx >> 6);
        const double step = exp((double)a.log_step[g]);
        const double lre = (double)a.lam_re[idx], lim = (double)a.lam_im[idx];
        const double mag = exp(lre * step), ang = lim * step;
        const double lbr_d = mag * cos(ang), lbi_d = mag * sin(ang);
        const double den = lre * lre + lim * lim, nr = lbr_d - 1.0, ni = lbi_d;
        const double cr = (nr * lre + ni * lim) / den, ci = (ni * lre - nr * lim) / den;
        const float lbr = (float)lbr_d, lbi = (float)lbi_d;
        double pr = (double)lbr, pi = (double)lbi;
#pragma unroll 1
        for (int i = 0; i < 11; ++i) { const double r2 = pr * pr - pi * pi, i2 = 2.0 * pr * pi; pr = r2; pi = i2; }
        *(f32x4*)(S5C + idx * 8) = (f32x4){lbr, lbi, (float)cr, (float)ci}; *(f32x4*)(S5C + idx * 8 + 4) = (f32x4){(float)pr, (float)pi, 0.f, 0.f};
    }
}
constexpr int S5W = 4, S5_SEG = M / S5W, S5_NCH = S5_SEG / 128, S5_NNB = S5_SEG / 256, S5_TQ = 8 / S5W;
constexpr int S5_APP = 264;
constexpr int S5_WLDS = 16896, S5_BU = 0, S5_SB = 8448, S5_US = 12800, S5_E = 8 * S5_WLDS;
typedef float f32x2v __attribute__((ext_vector_type(2)));
#define MFMA16(a, b, c) __builtin_amdgcn_mfma_f32_16x16x32_bf16((a), (b), (c), 0, 0, 0)
__device__ __forceinline__ void s5_bu_to_lds(const bf16x8 (&Af)[8], const bf16x8 Bf, LAS float* Bu, int lane) {
#pragma unroll
    for (int mb = 0; mb < 8; ++mb) { const f32x4 d = MFMA16(Af[mb], Bf, ((f32x4){0.f, 0.f, 0.f, 0.f})); *(LAS f32x4*)(Bu + (lane & 15) * 132 + 16 * mb + 4 * (lane >> 4)) = d; }
    LDS_WAIT(); asm volatile("" ::: "memory");
}
template <bool FULL> __device__ __forceinline__ void s5_sub(const bf16x8 (&Af)[8], const bf16x8 (&Cf)[4], const f32x4 d4, const bf16x8 Bf, const v2u u4raw, float& sr, float& si, float lbr, float lbi,
                                                            LAS float* Bu, LAS bf16* Sb, bf16* yrow, int lane) {
    s5_bu_to_lds(Af, Bf, Bu, lane);
    f32x2v b[16];
#pragma unroll
    for (int t = 0; t < 16; ++t) b[t] = *(const LAS f32x2v*)(Bu + t * 132 + 2 * lane);
#pragma unroll
    for (int t = 0; t < 16; ++t) { const float nsr = fmaf(lbr, sr, fmaf(-lbi, si, b[t].x)), nsi = fmaf(lbr, si, fmaf(lbi, sr, b[t].y)); sr = nsr; si = nsi;
        if (FULL) *(LAS unsigned*)(Sb + t * 136 + 2 * lane) = pk2(sr, si); }
    if (FULL) {
        LDS_WAIT(); asm volatile("" ::: "memory");
        f32x4 acc = (f32x4){0.f, 0.f, 0.f, 0.f};
#pragma unroll
        for (int kb = 0; kb < 4; ++kb) { const bf16x8 Sf = *(const LAS bf16x8*)(Sb + (lane & 15) * 136 + 32 * kb + 8 * (lane >> 4)); acc = MFMA16(Cf[kb], Sf, acc); }
        const float u0 = bf_lo(u4raw.x), u1 = bf_hi(u4raw.x), u2 = bf_lo(u4raw.y), u3 = bf_hi(u4raw.y);
        const float y0 = gelu_tanh(acc[0] + d4[0] * u0), y1 = gelu_tanh(acc[1] + d4[1] * u1), y2 = gelu_tanh(acc[2] + d4[2] * u2), y3 = gelu_tanh(acc[3] + d4[3] * u3);
        v2u o; o.x = pk2(y0, y1); o.y = pk2(y2, y3);
        *(GAS v2u*)(yrow + (size_t)(lane & 15) * D + 4 * (lane >> 4)) = o;
        asm volatile("" ::: "memory");
    }
}
__device__ __forceinline__ void s5_fast_group(const Args& a, int g, LAS unsigned char* L, int vcu, int G, int wave, int lane) {
    const bf16* U = (const bf16*)(a.ws + WS_U); bf16* YS5 = (bf16*)(a.ws + WS_YS5);
    LAS float* Bu = (LAS float*)(L + wave * S5_WLDS + S5_BU); LAS bf16* Sb = (LAS bf16*)(L + wave * S5_WLDS + S5_SB); LAS f32x2v* E = (LAS f32x2v*)(L + S5_E);
    float lbr, lbi, pwr, pwi;
    const float* S5C = (const float*)(a.ws + WS_S5C);
    { const f32x4 c0 = *(const f32x4*)(S5C + (size_t)(g * 64 + lane) * 8); const f32x2v c1 = *(const f32x2v*)(S5C + (size_t)(g * 64 + lane) * 8 + 4);
      lbr = c0[0]; lbi = c0[1]; pwr = c1.x; pwi = c1.y; }
    const bf16* ug = U + (size_t)g * M * 16; const int tw = wave * S5_SEG;
    LAS unsigned char* Us = L + wave * S5_WLDS + S5_US;
    const GAS v4u* useg = (const GAS v4u*)(ug + (size_t)tw * 16);
    const int bf_off = 32 * (lane & 15) + 16 * (lane >> 4), u4_off = 32 * (lane & 15) + 8 * (lane >> 4);
    {   LAS bf16* AP = (LAS bf16*)L;
#pragma unroll 1
        for (int tq = wave * S5_TQ; tq < (wave + 1) * S5_TQ; ++tq) { const int n = lane; const int e0 = 14 - 2 * tq;
          const f32x4 c0 = *(const f32x4*)(S5C + (size_t)(g * 64 + n) * 8);
          float pr = 1.f, pi = 0.f;
          for (int k = 0; k < e0; ++k) { const float r2 = pr * c0[0] - pi * c0[1], i2 = pr * c0[1] + pi * c0[0]; pr = r2; pi = i2; }
          const float qr = pr * c0[0] - pi * c0[1], qi = pr * c0[1] + pi * c0[0];
          const float* pbr = a.b_re + (size_t)(g * 64 + n) * 16; const float* pbi = a.b_im + (size_t)(g * 64 + n) * 16;
          LAS bf16* rre = AP + (32 * (n >> 4) + (n & 15)) * S5_APP + 32 * tq; LAS bf16* rim = rre + 16 * S5_APP;
#pragma unroll
          for (int q4 = 0; q4 < 4; ++q4) { const f32x4 br = *(const f32x4*)(pbr + 4 * q4), bi = *(const f32x4*)(pbi + 4 * q4);
              float xr[4], xi[4], yr[4], yi[4];
#pragma unroll
              for (int e = 0; e < 4; ++e) { const float bbr = c0[2] * br[e] - c0[3] * bi[e], bbi = c0[2] * bi[e] + c0[3] * br[e];
                  xr[e] = qr * bbr - qi * bbi; xi[e] = qr * bbi + qi * bbr; yr[e] = pr * bbr - pi * bbi; yi[e] = pr * bbi + pi * bbr; }
              *(LAS v2u*)(rre + 4 * q4) = (v2u){pk2(xr[0], xr[1]), pk2(xr[2], xr[3])}; *(LAS v2u*)(rim + 4 * q4) = (v2u){pk2(xi[0], xi[1]), pk2(xi[2], xi[3])};
              *(LAS v2u*)(rre + 16 + 4 * q4) = (v2u){pk2(yr[0], yr[1]), pk2(yr[2], yr[3])}; *(LAS v2u*)(rim + 16 + 4 * q4) = (v2u){pk2(yi[0], yi[1]), pk2(yi[2], yi[3])}; } }
        __syncthreads();
        float mur[4], mui[4], m13r[4], m13i[4], wqr[4], wqi[4];
#pragma unroll
        for (int mp = 0; mp < 4; ++mp) { const f32x2v lb = *(const f32x2v*)(S5C + (size_t)(g * 64 + 16 * mp + (lane & 15)) * 8);
            float r = lb.x, i = lb.y;
#pragma unroll
            for (int k = 0; k < 4; ++k) { const float r2 = r * r - i * i, i2 = 2.f * r * i; r = r2; i = i2; }
            const float m2r = r * r - i * i, m2i = 2.f * r * i, m4r = m2r * m2r - m2i * m2i, m4i = 2.f * m2r * m2i, m8r = m4r * m4r - m4i * m4i, m8i = 2.f * m4r * m4i;
            const float m12r = m8r * m4r - m8i * m4i, m12i = m8r * m4i + m8i * m4r;
            mur[mp] = r; mui[mp] = i; m13r[mp] = m12r; m13i[mp] = m12i;
            const int q = lane >> 4; wqr[mp] = q == 0 ? m12r : (q == 1 ? m8r : (q == 2 ? m4r : 1.f)); wqi[mp] = q == 0 ? m12i : (q == 1 ? m8i : (q == 2 ? m4i : 0.f)); }
        float zr[4] = {0.f, 0.f, 0.f, 0.f}, zi[4] = {0.f, 0.f, 0.f, 0.f};
#pragma unroll 1
        for (int nb = 0; nb < S5_NNB; ++nb) {
            bf16x8 Uf[8];
            const bf16* up = ug + (size_t)(tw + 16 * (16 * nb + (lane & 15))) * 16 + 8 * (lane >> 4);
#pragma unroll
            for (int kb = 0; kb < 8; ++kb) Uf[kb] = __builtin_bit_cast(bf16x8, *(const GAS v4u*)(up + 32 * kb));
            f32x4 acc[8];
#pragma unroll
            for (int mb = 0; mb < 8; ++mb) acc[mb] = (f32x4){0.f, 0.f, 0.f, 0.f};
#pragma unroll
            for (int kb = 0; kb < 8; ++kb)
#pragma unroll
                for (int mb = 0; mb < 8; ++mb) { const bf16x8 Af = *(const LAS bf16x8*)(AP + (16 * mb + (lane & 15)) * S5_APP + 32 * kb + 8 * (lane >> 4)); acc[mb] = MFMA16(Uf[kb], Af, acc[mb]); if (mb == 7) asm volatile("" ::: "memory"); }
#pragma unroll
            for (int mp = 0; mp < 4; ++mp) {
                if (nb > 0) { const float r2 = zr[mp] * m13r[mp] - zi[mp] * m13i[mp], i2 = zr[mp] * m13i[mp] + zi[mp] * m13r[mp]; zr[mp] = r2; zi[mp] = i2; }
#pragma unroll
                for (int r = 0; r < 4; ++r) { const float r2 = zr[mp] * mur[mp] - zi[mp] * mui[mp] + acc[2 * mp][r], i2 = zr[mp] * mui[mp] + zi[mp] * mur[mp] + acc[2 * mp + 1][r]; zr[mp] = r2; zi[mp] = i2; } }
        }
        __syncthreads();
#pragma unroll
        for (int mp = 0; mp < 4; ++mp) { float xr = zr[mp] * wqr[mp] - zi[mp] * wqi[mp], xi = zr[mp] * wqi[mp] + zi[mp] * wqr[mp];
            xr += __shfl_xor(xr, 16); xi += __shfl_xor(xi, 16); xr += __shfl_xor(xr, 32); xi += __shfl_xor(xi, 32);
            if (lane < 16) E[wave * 64 + 16 * mp + lane] = (f32x2v){xr, xi}; }
    }
    __syncthreads();
    float sr = 0.f, si = 0.f;
    for (int w2 = 0; w2 < wave; ++w2) { const f32x2v e = E[w2 * 64 + lane]; const float nsr = pwr * sr - pwi * si + e.x, nsi = pwr * si + pwi * sr + e.y; sr = nsr; si = nsi; }
    bf16x8 Af[8];
#pragma unroll
    for (int mb = 0; mb < 8; ++mb) {
        const int nr_ = 8 * mb + ((lane & 15) >> 1), part = lane & 1; v4u w = (v4u){0u, 0u, 0u, 0u};
        if (lane < 32) { const f32x2v cf = *(const f32x2v*)(S5C + (size_t)(g * 64 + nr_) * 8 + 2);
            const float* pr = a.b_re + (size_t)(g * 64 + nr_) * 16 + 8 * (lane >> 4); const float* pi = a.b_im + (size_t)(g * 64 + nr_) * 16 + 8 * (lane >> 4);
            const f32x4 r0 = *(const f32x4*)pr, r1 = *(const f32x4*)(pr + 4), i0 = *(const f32x4*)pi, i1 = *(const f32x4*)(pi + 4);
            f32x4 v0, v1;
#pragma unroll
            for (int e = 0; e < 4; ++e) { v0[e] = part ? (cf.x * i0[e] + cf.y * r0[e]) : (cf.x * r0[e] - cf.y * i0[e]); v1[e] = part ? (cf.x * i1[e] + cf.y * r1[e]) : (cf.x * r1[e] - cf.y * i1[e]); }
            w.x = pk2(v0[0], v0[1]); w.y = pk2(v0[2], v0[3]); w.z = pk2(v1[0], v1[1]); w.w = pk2(v1[2], v1[3]); }
        Af[mb] = __builtin_bit_cast(bf16x8, w);
    }
    bf16x8 Cf[4];
#pragma unroll
    for (int kb = 0; kb < 4; ++kb) { const int p = lane & 15, n0 = 16 * kb + 4 * (lane >> 4);
        const f32x4 cr4 = *(const f32x4*)(a.c_re + (size_t)(g * 16 + p) * 64 + n0), ci4 = *(const f32x4*)(a.c_im + (size_t)(g * 16 + p) * 64 + n0);
        v4u w; w.x = pk2(cr4[0], -ci4[0]); w.y = pk2(cr4[1], -ci4[1]); w.z = pk2(cr4[2], -ci4[2]); w.w = pk2(cr4[3], -ci4[3]); Cf[kb] = __builtin_bit_cast(bf16x8, w); }
    const f32x4 d4 = *(const f32x4*)(a.s5_d + g * 16 + 4 * (lane >> 4));
    asm volatile("" ::: "memory");
    { v4u R[4];
#pragma unroll
      for (int i = 0; i < 4; ++i) R[i] = useg[lane + 64 * i];
#pragma unroll 1
      for (int ch = 0; ch < S5_NCH; ++ch) {
#pragma unroll
          for (int i = 0; i < 4; ++i) *(LAS v4u*)(Us + 16 * (lane + 64 * i)) = R[i];
          LDS_WAIT(); asm volatile("" ::: "memory");
          const int chn = ch < S5_NCH - 1 ? ch + 1 : ch;
#pragma unroll
          for (int i = 0; i < 4; ++i) R[i] = useg[256 * chn + lane + 64 * i];
#pragma unroll 1
          for (int sb = 0; sb < 8; ++sb) {
              v4u bw = *(const LAS v4u*)(Us + 512 * sb + (lane < 32 ? bf_off : 0)); if (lane >= 32) bw = (v4u){0u, 0u, 0u, 0u};
              const v2u uw = *(const LAS v2u*)(Us + 512 * sb + u4_off);
              s5_sub<true>(Af, Cf, d4, __builtin_bit_cast(bf16x8, bw), uw, sr, si, lbr, lbi, Bu, Sb, YS5 + (size_t)(tw + 128 * ch + 16 * sb) * D + g * 16, lane);
          }
      } }
    p3_stream_items(a, L, (LAS bf16*)(L + wave * S5_WLDS), vcu, G, lane);
    __syncthreads();
}

__device__ __forceinline__ void p3_mem_role(const Args& a, LAS unsigned char* L, int vcu, int G, int wave, int lane) {
    __syncthreads(); __syncthreads(); __syncthreads();
    p3_stream_items(a, L, (LAS bf16*)(L + S5W * S5_WLDS + (wave - S5W) * TR_BYTES), vcu, G, lane);
    __syncthreads();
}
static_assert(S5W * S5_WLDS + (NWAVES - S5W) * TR_BYTES <= S5_E && S5W * S5_WLDS >= 128 * S5_APP * 2, "P3 LDS map: S5 per-wave regions / AP image, then the memory role's transpose scratch, then E");
constexpr size_t WS_BT = 872 * MiB, WS_ACUM = 888 * MiB, WS_CF = 892 * MiB, WS_SC = 1000 * MiB;
static_assert(WS_SC + (size_t)64 * 8 * 128 * 128 * 2 <= WS_H && WS_ACUM + (size_t)M * NH * 4 <= WS_CF && WS_CF + (size_t)64 * 8 * 16384 * 2 <= WS_SC, "ssd scratch map");
constexpr size_t WS_SSQ = 908 * MiB, WS_RT = 916 * MiB;
constexpr int SP_ROW = 136;
__device__ __forceinline__ void ssd_prep_dt(const Args& a, int item, LAS float* tot, int tid) {
    const float* DTP = a.out; float* DTS = (float*)(a.ws + WS_DTS); float* ACUM = (float*)(a.ws + WS_ACUM);
    const int c = item >> 2, h = 32 * (item & 3) + (tid & 31), q = tid >> 5;
    const float av = -expf(a.a_log[h]) * 1.44269504088896f, bias = a.dt_bias[h];
    float raw[8];
#pragma unroll
    for (int i = 0; i < 8; ++i) { const size_t idx = (size_t)(128 * c + 8 * q + i) * NH + h; float r = bias;
#pragma unroll
        for (int ks = 0; ks < 8; ++ks) r += DTP[(size_t)ks * M * NH + idx];
        raw[i] = r; }
    float loc[8]; float run = 0.f;
#pragma unroll
    for (int i = 0; i < 8; ++i) { const float dt = softplus_f(raw[i]); raw[i] = dt; run += dt * av; loc[i] = run; }
    { float* dp = DTS + (size_t)h * M + 128 * c + 8 * q; *(f32x4*)dp = (f32x4){raw[0], raw[1], raw[2], raw[3]}; *(f32x4*)(dp + 4) = (f32x4){raw[4], raw[5], raw[6], raw[7]}; }
    tot[q * 32 + (tid & 31)] = run;
    __syncthreads();
    float off = 0.f;
#pragma unroll
    for (int q2 = 0; q2 < 15; ++q2) off += (q2 < q) ? tot[q2 * 32 + (tid & 31)] : 0.f;
    { float* ap = ACUM + (size_t)h * M + 128 * c + 8 * q; *(f32x4*)ap = (f32x4){loc[0] + off, loc[1] + off, loc[2] + off, loc[3] + off}; *(f32x4*)(ap + 4) = (f32x4){loc[4] + off, loc[5] + off, loc[6] + off, loc[7] + off}; }
    __syncthreads();
}
template <int STAGE> __device__ __forceinline__ void ssd_prep_cg(const Args& a, int c, int g, LAS unsigned char* L, int tid, int wave, int lane) {
    const bf16* XBC = (const bf16*)(a.ws + WS_XBC); bf16* SC = (bf16*)(a.ws + WS_SC) + (size_t)(c * 8 + g) * 16384; bf16* BT = (bf16*)(a.ws + WS_BT) + (size_t)(c * 8 + g) * 16384; bf16* CF = (bf16*)(a.ws + WS_CF) + (size_t)(c * 8 + g) * 16384;
    LAS bf16* Bs = (LAS bf16*)L; LAS bf16* Cs = (LAS bf16*)(L + 128 * SP_ROW * 2);
    const int o = tid & 15;
    if constexpr (STAGE == 0) {
#pragma unroll
    for (int mat = 0; mat < 2; ++mat) {
        const int col0 = DI + mat * (NG * NS) + g * NS + 8 * o;
        f32x4 w0[4], w1[4];
#pragma unroll
        for (int k = 0; k < 4; ++k) { w0[k] = *(const f32x4*)(a.conv_w + k * CONVD + col0); w1[k] = *(const f32x4*)(a.conv_w + k * CONVD + col0 + 4); }
        const f32x4 b0 = *(const f32x4*)(a.conv_b + col0), b1 = *(const f32x4*)(a.conv_b + col0 + 4);
#pragma unroll
        for (int i = 0; i < 4; ++i) { const int tl = (tid >> 4) + 32 * i, t = 128 * c + tl;
            f32x4 acc0 = b0, acc1 = b1;
#pragma unroll
            for (int k = 0; k < 4; ++k) { const int tt = t - 3 + k;
                if (tt >= 0) { f32x4 r0, r1; pg8::unpack8(*(const GAS v4u*)(XBC + (size_t)tt * CONVD + col0), r0, r1); acc0 = acc0 + r0 * w0[k]; acc1 = acc1 + r1 * w1[k]; } }
#pragma unroll
            for (int e = 0; e < 4; ++e) { acc0[e] = pg8::silu_f(acc0[e]); acc1[e] = pg8::silu_f(acc1[e]); }
            v4u ov; ov.x = pk2(acc0.x, acc0.y); ov.y = pk2(acc0.z, acc0.w); ov.z = pk2(acc1.x, acc1.y); ov.w = pk2(acc1.z, acc1.w);
            *(LAS v4u*)((mat ? Cs : Bs) + tl * SP_ROW + 8 * o) = ov; }
    }
    } else {
    { f32x4 acc[8];
#pragma unroll
      for (int sb = 0; sb < 8; ++sb) acc[sb] = (f32x4){0.f, 0.f, 0.f, 0.f};
#pragma unroll
      for (int kb = 0; kb < 4; ++kb) { const bf16x8 cf = *(const LAS bf16x8*)(Cs + (16 * wave + (lane & 15)) * SP_ROW + 32 * kb + 8 * (lane >> 4));
          *(GAS v4u*)(CF + (size_t)((wave * 4 + kb) * 64 + lane) * 8) = __builtin_bit_cast(v4u, cf);
#pragma unroll
          for (int sb = 0; sb < 8; ++sb) { const bf16x8 bfr = *(const LAS bf16x8*)(Bs + (16 * sb + (lane & 15)) * SP_ROW + 32 * kb + 8 * (lane >> 4)); acc[sb] = MFMA16(bfr, cf, acc[sb]); } }
#pragma unroll
      for (int sb = 0; sb < 8; ++sb) { v2u ov; ov.x = pk2(acc[sb][0], acc[sb][1]); ov.y = pk2(acc[sb][2], acc[sb][3]);
          const int q = lane >> 4, lanep = (lane & 15) + 16 * (2 * (sb & 1) + (q >> 1));
          *(GAS v2u*)(SC + (size_t)((wave * 4 + (sb >> 1)) * 64 + lanep) * 8 + 4 * (q & 1)) = ov; } }
#pragma unroll
    for (int kb = 0; kb < 4; ++kb) { unsigned short v[8];
#pragma unroll
        for (int e = 0; e < 8; ++e) v[e] = Bs[(32 * kb + 8 * (lane >> 4) + e) * SP_ROW + 16 * wave + (lane & 15)];
        v4u ov; ov.x = v[0] | ((unsigned)v[1] << 16); ov.y = v[2] | ((unsigned)v[3] << 16); ov.z = v[4] | ((unsigned)v[5] << 16); ov.w = v[6] | ((unsigned)v[7] << 16);
        *(GAS v4u*)(BT + (size_t)((wave * 4 + kb) * 64 + lane) * 8) = ov; }
    }
}
constexpr int PREP_LDS = 2 * 128 * SP_ROW * 2;
constexpr int SM_XD = 0, SM_XW = 8192, SM_XP = 16384, SM_ZP = 24576, SM_AC = 32768, SM_XE = 33280, SM_BUF = 41472, SM_SB = 2 * SM_BUF, SM_SBSZ = 8704;
typedef short s16x4 __attribute__((ext_vector_type(4)));
__device__ __forceinline__ bf16x8 ssd_tr_frag(const LAS unsigned char* img, int kb, int pb, int lane) {
    const LAS unsigned char* ad = img + (32 * kb + 8 * (lane >> 4) + ((lane & 15) >> 2)) * 64 + (16 * pb + 4 * (lane & 3)) * 2;
    const s16x4 lo = __builtin_amdgcn_ds_read_tr16_b64_v4i16((LAS s16x4*)ad), hi = __builtin_amdgcn_ds_read_tr16_b64_v4i16((LAS s16x4*)(ad + 4 * 64));
    return __builtin_shufflevector(lo, hi, 0, 1, 2, 3, 4, 5, 6, 7);
}
__device__ __forceinline__ bf16x8 ssd_tr_frag_y(const LAS unsigned char* img, int kb, int pb, int lane) {
    const LAS unsigned char* ad = img + (32 * kb + 8 * (lane >> 4) + ((lane & 15) >> 2)) * 64 + (8 * (lane & 3) + 4 * pb) * 2;
    const s16x4 lo = __builtin_amdgcn_ds_read_tr16_b64_v4i16((LAS s16x4*)ad), hi = __builtin_amdgcn_ds_read_tr16_b64_v4i16((LAS s16x4*)(ad + 4 * 64));
    return __builtin_shufflevector(lo, hi, 0, 1, 2, 3, 4, 5, 6, 7);
}
struct SsdStage { v4u x, z; float dt, ac, acend, acb; };
__device__ __forceinline__ void ssd_stage_load(SsdStage& s, const bf16* XC, const bf16* MZ, const float* DTS, const float* ACUM, int c, int h, int ph, int tid) {
    const int t = 128 * c + (tid >> 2), piece = tid & 3;
    s.x = __builtin_nontemporal_load((const GAS v4u*)(XC + (size_t)t * CONVD + h * HD + 32 * ph + 8 * piece));
    s.z = __builtin_nontemporal_load((const GAS v4u*)(MZ + (size_t)t * DI + h * HD + 32 * ph + 8 * piece));
    s.dt = DTS[(size_t)h * M + t]; s.ac = ACUM[(size_t)h * M + t]; s.acend = ACUM[(size_t)h * M + 128 * c + 127]; s.acb = ACUM[(size_t)h * M + 128 * c + ((tid >> 2) | 31)];
}
__device__ __forceinline__ void ssd_stage_store(const SsdStage& s, LAS unsigned char* buf, int tid) {
    const int tl = tid >> 2, piece = tid & 3;
    const float te = __builtin_amdgcn_exp2f(s.acend - s.ac), tb = __builtin_amdgcn_exp2f(s.acb - s.ac);
    const unsigned xs[4] = {s.x.x, s.x.y, s.x.z, s.x.w}; unsigned d[4], w[4], eb[4];
#pragma unroll
    for (int e2 = 0; e2 < 4; ++e2) { const float x0 = bf_lo(xs[e2]) * s.dt, x1 = bf_hi(xs[e2]) * s.dt; d[e2] = pk2(x0, x1); w[e2] = pk2(x0 * te, x1 * te); eb[e2] = pk2(x0 * tb, x1 * tb); }
    *(LAS v4u*)(buf + SM_XE + tl * 64 + 16 * piece) = (v4u){eb[0], eb[1], eb[2], eb[3]};
    *(LAS v4u*)(buf + SM_XD + tl * 64 + 16 * piece) = (v4u){d[0], d[1], d[2], d[3]};
    *(LAS v4u*)(buf + SM_XW + tl * 64 + 16 * piece) = (v4u){w[0], w[1], w[2], w[3]};
    *(LAS v4u*)(buf + SM_XP + tl * 64 + 16 * piece) = s.x;
    *(LAS v4u*)(buf + SM_ZP + tl * 64 + 16 * piece) = s.z;
    if (piece == 0) *(LAS float*)(buf + SM_AC + 4 * tl) = s.ac;
}
struct SsdFrags { bf16x8 sc[3], scd, cc[4], bt[4]; };
__device__ __forceinline__ void ssd_frag_load(SsdFrags& f, const bf16* SC, const bf16* CF, const bf16* BT, int c, int g, int wave, int lane) {
    const size_t base = ((size_t)((c * 8 + g) * 8 + wave) * 4 * 64 + lane) * 8; const int kd = wave >> 1;
#pragma unroll
    for (int kb = 0; kb < 4; ++kb) { if (kb < 3) { if (kb < kd) f.sc[kb] = __builtin_bit_cast(bf16x8, *(const GAS v4u*)(SC + base + kb * 512)); } else f.scd = __builtin_bit_cast(bf16x8, *(const GAS v4u*)(SC + base + kd * 512));
        f.cc[kb] = __builtin_bit_cast(bf16x8, *(const GAS v4u*)(CF + base + kb * 512)); f.bt[kb] = __builtin_bit_cast(bf16x8, *(const GAS v4u*)(BT + base + kb * 512)); }
}
#define SSD_BAR() do { LDS_WAIT(); asm volatile("" ::: "memory"); __builtin_amdgcn_s_barrier(); asm volatile("" ::: "memory"); } while (0)
template <int DBG> __device__ __forceinline__ void ssd_chunk(const SsdFrags& fr, SsdFrags& frn, const SsdStage& sgs, SsdStage& sgl, f32x4 (&st)[2], int c, int cn, int cl, const bf16* XC, const bf16* MZ, const float* DTS, const float* ACUM, const bf16* SC, const bf16* CF, const bf16* BT, bf16* YSSD, float* SSQ,
                                          int h, int ph, int g, float Dh, LAS unsigned char* L, int tid, int wave, int lane, bool late) {
    LAS unsigned char* buf = L + (c & 1) * SM_BUF; LAS unsigned char* nbuf = L + ((c + 1) & 1) * SM_BUF;
    const LAS bf16* SBo = (const LAS bf16*)(L + SM_SB + (c & 1) * SM_SBSZ); LAS bf16* SBn = (LAS bf16*)(L + SM_SB + ((c + 1) & 1) * SM_SBSZ);
    const LAS unsigned char* XD = buf + SM_XD; const LAS unsigned char* XW = buf + SM_XW; const LAS float* AC = (const LAS float*)(buf + SM_AC);
    if (!(DBG & 2)) ssd_frag_load(frn, SC, CF, BT, cn, g, wave, lane);
    if (!(DBG & 4)) ssd_stage_load(sgl, XC, MZ, DTS, ACUM, cl, h, ph, tid);
    const int trow = 16 * wave + (lane & 15), ko = 8 * (lane >> 4), kd = wave >> 1;
    auto state_and_stage = [&]() __attribute__((always_inline)) {
    { const float dec = __builtin_amdgcn_exp2f(AC[127]); st[0] = st[0] * dec; st[1] = st[1] * dec;
      if (!(DBG & 16))
#pragma unroll
      for (int kb = 0; kb < 4; ++kb)
#pragma unroll
          for (int pb = 0; pb < 2; ++pb) { const bf16x8 Bf = ssd_tr_frag(XW, kb, pb, lane); st[pb] = MFMA16(fr.bt[kb], Bf, st[pb]); }
#pragma unroll
      for (int pb = 0; pb < 2; ++pb) { v2u ov; ov.x = pk2(st[pb][0], st[pb][1]); ov.y = pk2(st[pb][2], st[pb][3]); *(LAS v2u*)(SBn + (16 * pb + (lane & 15)) * SP_ROW + 16 * wave + 4 * (lane >> 4)) = ov; } }
    if (!(DBG & 8)) ssd_stage_store(sgs, nbuf, tid); };
    if (late) state_and_stage();
    const LAS unsigned char* XE = buf + SM_XE;
    bf16x8 Sf[4][2];
#pragma unroll
    for (int kb = 0; kb < 4; ++kb)
#pragma unroll
        for (int pb = 0; pb < 2; ++pb) Sf[kb][pb] = *(const LAS bf16x8*)(SBo + (8 * ((lane & 15) >> 2) + 4 * pb + (lane & 3)) * SP_ROW + 32 * kb + ko);
    const float act = AC[trow];
    const f32x4 as0 = *(const LAS f32x4*)(AC + 32 * kd + ko), as1 = *(const LAS f32x4*)(AC + 32 * kd + ko + 4);
    const float ae0 = AC[31], ae1 = AC[63], ae2 = AC[95];
    const v4u xv = *(const LAS v4u*)(buf + SM_XP + trow * 64 + 16 * (lane >> 4)), zv = *(const LAS v4u*)(buf + SM_ZP + trow * 64 + 16 * (lane >> 4));
    const v2u xw[2] = {(v2u){xv.x, xv.y}, (v2u){xv.z, xv.w}}, zw[2] = {(v2u){zv.x, zv.y}, (v2u){zv.z, zv.w}};
    __builtin_amdgcn_sched_barrier(0);
    const f32x4 zero4 = (f32x4){0.f, 0.f, 0.f, 0.f};
    f32x4 accD[2] = {zero4, zero4}, accO[2] = {zero4, zero4}, P[3][2];
    if (!(DBG & 16))
#pragma unroll
    for (int kb = 0; kb < 4; ++kb)
#pragma unroll
        for (int pb = 0; pb < 2; ++pb) accO[pb] = MFMA16(Sf[kb][pb], fr.cc[kb], accO[pb]);
#pragma unroll
    for (int kb = 0; kb < 3; ++kb) if (kb < kd && !(DBG & 16)) {
#pragma unroll
        for (int pb = 0; pb < 2; ++pb) P[kb][pb] = MFMA16(ssd_tr_frag_y(XE, kb, pb, lane), fr.sc[kb], zero4); }
    if (!(DBG & 16)) { const v4u sw = __builtin_bit_cast(v4u, fr.scd); const unsigned sws[4] = {sw.x, sw.y, sw.z, sw.w}; unsigned ow[4];
      const int dl = 16 * (wave & 1) + (lane & 15) - ko;
#pragma unroll
      for (int e2 = 0; e2 < 4; ++e2) { const float a0 = e2 < 2 ? as0[2 * e2] : as1[2 * e2 - 4], a1 = e2 < 2 ? as0[2 * e2 + 1] : as1[2 * e2 - 3];
          float v0 = bf_lo(sws[e2]) * __builtin_amdgcn_exp2f(act - a0), v1 = bf_hi(sws[e2]) * __builtin_amdgcn_exp2f(act - a1);
          v0 = (2 * e2 <= dl) ? v0 : 0.f; v1 = (2 * e2 + 1 <= dl) ? v1 : 0.f;
          ow[e2] = pk2(v0, v1); }
      const bf16x8 Lf = __builtin_bit_cast(bf16x8, ((v4u){ow[0], ow[1], ow[2], ow[3]}));
#pragma unroll
      for (int pb = 0; pb < 2; ++pb) { const bf16x8 Xf = ssd_tr_frag_y(XD, kd, pb, lane); accD[pb] = MFMA16(Xf, Lf, accD[pb]); } }
    { const float ea = __builtin_amdgcn_exp2f(act); float ssq = 0.f;
      const float aes[3] = {ae0, ae1, ae2};
#pragma unroll
      for (int kb = 0; kb < 3; ++kb) if (kb < kd && !(DBG & 16)) { const float r = __builtin_amdgcn_exp2f(act - aes[kb]);
#pragma unroll
          for (int pb = 0; pb < 2; ++pb) accD[pb] = accD[pb] + r * P[kb][pb]; }
      unsigned yo[4];
#pragma unroll
      for (int pb = 0; pb < 2; ++pb) {
          const float y0 = (accD[pb][0] + ea * accO[pb][0] + Dh * bf_lo(xw[pb].x)) * bf_lo(zw[pb].x), y1 = (accD[pb][1] + ea * accO[pb][1] + Dh * bf_hi(xw[pb].x)) * bf_hi(zw[pb].x);
          const float y2 = (accD[pb][2] + ea * accO[pb][2] + Dh * bf_lo(xw[pb].y)) * bf_lo(zw[pb].y), y3 = (accD[pb][3] + ea * accO[pb][3] + Dh * bf_hi(xw[pb].y)) * bf_hi(zw[pb].y);
          ssq += (y0 * y0 + y1 * y1) + (y2 * y2 + y3 * y3);
          yo[2 * pb] = pk2(y0, y1); yo[2 * pb + 1] = pk2(y2, y3); }
      if (!(DBG & 1)) __builtin_nontemporal_store(((v4u){yo[0], yo[1], yo[2], yo[3]}), (GAS v4u*)(YSSD + (size_t)(128 * c + trow) * DI + h * HD + 32 * ph + 8 * (lane >> 4)));
      ssq += __shfl_xor(ssq, 16); ssq += __shfl_xor(ssq, 32);
      if (lane < 16 && !(DBG & 32)) SSQ[((size_t)(8 * c + wave) * 256 + 2 * h + ph) * 16 + lane] = ssq; }
    if (!late) state_and_stage();
    SSD_BAR();
}
template <int DBG> __device__ __forceinline__ void ssd_main_item(const Args& a, int item, LAS unsigned char* L, int tid, int wave, int lane) {
    const bf16* XC = (const bf16*)(a.ws + WS_XC); const bf16* MZ = (const bf16*)(a.ws + WS_MZ); const float* DTS = (const float*)(a.ws + WS_DTS); const float* ACUM = (const float*)(a.ws + WS_ACUM);
    const bf16* SC = (const bf16*)(a.ws + WS_SC); const bf16* BT = (const bf16*)(a.ws + WS_BT); const bf16* CF = (const bf16*)(a.ws + WS_CF); bf16* YSSD = (bf16*)(a.ws + WS_YSSD); float* SSQ = (float*)(a.ws + WS_SSQ);
    const int h = item >> 1, ph = item & 1, g = h >> 4; const float Dh = a.m2_d[h];
    const int wave_hw = wave; wave = wave_hw < 4 ? 7 - wave_hw : wave_hw - 4;
    for (int i = tid; i < SM_SBSZ / 4; i += NWAVES * 64) *(LAS unsigned*)(L + SM_SB + 4 * i) = 0u;
    SsdStage sgE, sgO; SsdFrags frA, frB;
    ssd_stage_load(sgE, XC, MZ, DTS, ACUM, 0, h, ph, tid); ssd_frag_load(frA, SC, CF, BT, 0, g, wave, lane);
    ssd_stage_load(sgO, XC, MZ, DTS, ACUM, 1, h, ph, tid);
    ssd_stage_store(sgE, L, tid);
    f32x4 st[2] = {(f32x4){0.f, 0.f, 0.f, 0.f}, (f32x4){0.f, 0.f, 0.f, 0.f}};
    __syncthreads();
    const bool late = false;
#pragma unroll 1
    for (int c = 0; c < 64; c += 2) {
        ssd_chunk<DBG>(frA, frB, sgO, sgE, st, c, c + 1, c + 2 < 64 ? c + 2 : 63, XC, MZ, DTS, ACUM, SC, CF, BT, YSSD, SSQ, h, ph, g, Dh, L, tid, wave, lane, late);
        ssd_chunk<DBG>(frB, frA, sgE, sgO, st, c + 1, c + 2 < 64 ? c + 2 : 63, c + 3 < 64 ? c + 3 : 63, XC, MZ, DTS, ACUM, SC, CF, BT, YSSD, SSQ, h, ph, g, Dh, L, tid, wave, lane, late);
    }
    __syncthreads();
}

__device__ __forceinline__ void ssd_norm_stats(const Args& a, size_t gt, size_t NT) {
    const float* SSQ = (const float*)(a.ws + WS_SSQ); float* RT = (float*)(a.ws + WS_RT);
    for (size_t idx = gt; idx < (size_t)M * NG; idx += NT) {
        const int t = (int)(idx >> 6) * 8 + (int)(idx & 7), g = (int)(idx >> 3) & 7;
        const float* sp = SSQ + ((size_t)(t >> 4) * 256 + 32 * g) * 16 + (t & 15);
        float s = 0.f;
#pragma unroll 8
        for (int j = 0; j < 32; ++j) s += sp[j * 16];
        const float r = 1.0f / sqrtf(s * (1.0f / 1024.0f) + EPS);
        const float rn = __shfl_down(r, 8);
        RT[(size_t)t * 8 + g] = (g == 7) ? r : r / rn;
    }
}
__global__ void __launch_bounds__(NWAVES * 64, 2) hyb_fwd(Args args) {
    extern __shared__ __attribute__((aligned(16))) unsigned char lds[];
    LAS unsigned char* L = (LAS unsigned char*)lds;
    volatile LAS unsigned* MISC = (volatile LAS unsigned*)(L + MISC_OFF);
    const int tid = threadIdx.x, lane = tid & 63, wave = __builtin_amdgcn_readfirstlane(tid >> 6);
    const int G = gridDim.x; const int bx = blockIdx.x; const int vcu = (G % 8 == 0) ? (bx % 8) * (G / 8) + bx / 8 : bx;
    const int gw = vcu * NWAVES + wave, NGW = G * NWAVES;
    gu32* ctl = (gu32*)(args.ws + WS_CTL);
    for (int u = tid; u < (LDS_BYTES - LDSCTL_OFF) / 4; u += NWAVES * 64) ((LAS unsigned*)(L + LDSCTL_OFF))[u] = 0u;
    __syncthreads();
    XcdBarrier bar; bar.bar = (unsigned*)(ctl + CW_BAR); bar.x = 0; bar.st = nullptr;
    if (N_LAUNCHES == 1) bar = xcd_barrier_post((unsigned*)(ctl + CW_BAR), MISC + 8);
#define GRID_BAR() do { if (N_LAUNCHES == 1) xcd_barrier(bar); } while (0)
    const int lo = args.ph_lo, hi = args.ph_hi;
#define IN(k) (lo <= (k) && (k) < hi)
#define BOTH(k) (IN(k) && IN((k) + 1))
#if defined(PROBE_PHASE)
#define PROBE_DBG(x) (x)
#else
#define PROBE_DBG(x) 0
#endif
#define LAUNDER() int lane_p = lane, tid_p = tid; asm volatile("" : "+v"(lane_p), "+v"(tid_p))

    if (IN(0)) {
        LAUNDER();
        p0_gemv(args.c, args.w_ada, (float*)(args.ws + WS_MODP), (LAS float*)(L + RING_OFF), vcu, G, tid_p);
        p0_weights_in(args, (LAS bf16*)(L + RING_OFF + wave * 16384), gw, NGW, lane_p);
        s5_consts(args, (size_t)gw * 64 + lane_p, (size_t)NGW * 64);
        if (BOTH(0)) GRID_BAR();
    }
    if (IN(1)) {
        LAUNDER();
        p1_h(args, (LAS float*)(L + RING_OFF), (LAS float*)(L + RING_OFF + 16384), gw, NGW, tid_p, lane_p);
        if (BOTH(1)) GRID_BAR();
    }
    if (IN(2)) {
        { pg8::Gemm g{(const bf16*)(args.ws + WS_H), (const bf16*)(args.ws + WS_WIN), M, NMAIN, D, D}; pg8::StaticOrder S; S.init(M, NMAIN, G, bx);
          pg8::EpiProj E{(bf16*)(args.ws + WS_U), (bf16*)(args.ws + WS_SZ), (bf16*)(args.ws + WS_MZ), (bf16*)(args.ws + WS_XBC), (bf16*)(args.ws + WS_G1), (bf16*)(args.ws + WS_G2)};
          pg8::gemm_phase<pg8::EpiProj, pg8::StaticOrder, PG8_ALIGN, PG8_SP2>(L + RING_OFF, g, S, E); }
        { pg8::Gemm g{(const bf16*)(args.ws + WS_H), (const bf16*)(args.ws + WS_WIN) + (size_t)NMAIN * D, M, 8 * 256, 512, D}; pg8::StaticOrder S; S.init(M, 8 * 256, G, bx);
          pg8::EpiDTP E{args.out};
          pg8::gemm_phase<pg8::EpiDTP, pg8::StaticOrder, PG8_ALIGN, PG8_SP2, true>(L + RING_OFF, g, S, E); }
        if (BOTH(2)) GRID_BAR();
    }
    if (IN(3)) {
        LAUNDER();
        const int sub = args.sub;
        if (tid_p == 0) *(LAS unsigned*)(L + RING_OFF + P3_CNT_OFF) = (sub == 5) ? 0x100000u : 0u;
        if (sub == 0 || sub == 2) for (int it = vcu; it < 64 * NG; it += 2 * G) {
            const int it2 = it + G; const bool two = it2 < 64 * NG;
            ssd_prep_cg<0>(args, it >> 3, it & 7, L + RING_OFF, tid_p, wave, lane_p);
            if (two) ssd_prep_cg<0>(args, it2 >> 3, it2 & 7, L + RING_OFF + PREP_LDS, tid_p, wave, lane_p);
            __syncthreads();
            ssd_prep_cg<1>(args, it >> 3, it & 7, L + RING_OFF, tid_p, wave, lane_p);
            if (two) ssd_prep_cg<1>(args, it2 >> 3, it2 & 7, L + RING_OFF + PREP_LDS, tid_p, wave, lane_p);
            __syncthreads(); }
        if (sub == 0 || sub == 3) for (int it = vcu; it < 64 * 4; it += G) ssd_prep_dt(args, it, (LAS float*)(L + RING_OFF), tid_p);
        if (sub == 0 || sub == 1 || sub == 5) for (int g5 = vcu; g5 < S5G; g5 += G) {
            if (wave < S5W) s5_fast_group(args, g5, L + RING_OFF, vcu, G, wave, lane_p);
            else p3_mem_role(args, L + RING_OFF, vcu, G, wave, lane_p); }
        if (BOTH(3)) GRID_BAR();
    }
    if (IN(4)) { LAUNDER(); for (int it = vcu; it < NH * 2; it += G) {
#if defined(PROBE_PHASE) && PROBE_PHASE == 4
            if (args.sub) ssd_main_item<PROBE_SUB>(args, it, L + RING_OFF, tid_p, wave, lane_p); else
#endif
            ssd_main_item<0>(args, it, L + RING_OFF, tid_p, wave, lane_p); } if (BOTH(4)) GRID_BAR(); }
    if (IN(5)) { LAUNDER(); ssd_norm_stats(args, (size_t)gw * 64 + lane_p, (size_t)NGW * 64); }
    if (IN(6)) {
        pg8::Gemm g{(const bf16*)(args.ws + WS_YS5), (const bf16*)(args.ws + WS_WGLU), M, 8192, D, D}; pg8::StaticOrder S; S.init(M, 8192, G, bx);
        pg8::EpiGlu E{(const bf16*)(args.ws + WS_SZ), args.b_glu, (bf16*)(args.ws + WS_YS5G)};
        pg8::gemm_phase<pg8::EpiGlu, pg8::StaticOrder, PG8_ALIGN, PG8_SP2>(L + RING_OFF, g, S, E);
        if (BOTH(6)) GRID_BAR();
    }
    if (IN(7)) {
        pg8::Gemm g{(const bf16*)(args.ws + WS_YS5G), (const bf16*)(args.ws + WS_WBRS), M, D, D, D}; pg8::StaticOrder S; S.init(M, D, G, bx);
        pg8::EpiBrS E{(const bf16*)(args.ws + WS_G1), (bf16*)(args.ws + WS_T1)};
        pg8::gemm_phase<pg8::EpiBrS, pg8::StaticOrder, PG8_ALIGN, PG8_SP2>(L + RING_OFF, g, S, E);
    }
    if (IN(8)) {
        pg8::Gemm g{(const bf16*)(args.ws + WS_YSSD), (const bf16*)(args.ws + WS_WBRM), M, D, DI, DI}; pg8::StaticOrder S; S.init(M, D, G, bx);
        pg8::EpiBrM E{(const bf16*)(args.ws + WS_G2), (const bf16*)(args.ws + WS_T1), (bf16*)(args.ws + WS_MERGED), (const float*)(args.ws + WS_RT)};
        pg8::gemm_phase<pg8::EpiBrM, pg8::StaticOrder, PG8_ALIGN, PG8_SP2>(L + RING_OFF, g, S, E);
        if (BOTH(8)) GRID_BAR();
    }
    if (IN(9)) {
        pg8::Gemm g{(const bf16*)(args.ws + WS_MERGED), (const bf16*)(args.ws + WS_WOUT), M, D, D, D}; pg8::StaticOrder S; S.init(M, D, G, bx);
        pg8::EpiOut E{args.x, (const float*)(args.ws + WS_GATE), (bf16*)(args.ws + WS_X2), (float*)(args.ws + WS_SS)};
        pg8::gemm_phase<pg8::EpiOut, pg8::StaticOrder, PG8_ALIGN, PG8_SP2>(L + RING_OFF, g, S, E);
        if (BOTH(9)) GRID_BAR();
    }
    if (IN(10)) { LAUNDER(); final_norm(args, gw, NGW, lane_p); }

#if defined(DBG_STOP)
    if (IN(NPH)) {
        const size_t gt = (size_t)gw * 64 + lane, NT = (size_t)NGW * 64; const size_t R = (size_t)8 << 20;
        const unsigned char* b0 = args.ws + DBG_B0; const unsigned char* b1 = args.ws + DBG_B1; const unsigned char* b2 = args.ws + DBG_B2; const unsigned char* b3 = args.ws + DBG_B3;
        for (size_t i = gt; i < R; i += NT) {
            float s0 = 0.f, s1 = 0.f, s2 = 0.f, s3 = 0.f;
            for (size_t j = i; j < (size_t)DBG_N0; j += R) s0 += DBG_F0 ? ((const float*)b0)[j] : bf2f(((const bf16*)b0)[j]);
            for (size_t j = i; j < (size_t)DBG_N1; j += R) s1 += DBG_F1 ? ((const float*)b1)[j] : bf2f(((const bf16*)b1)[j]);
            for (size_t j = i; j < (size_t)DBG_N2; j += R) s2 += DBG_F2 ? ((const float*)b2)[j] : bf2f(((const bf16*)b2)[j]);
            for (size_t j = i; j < (size_t)DBG_N3; j += R) s3 += DBG_F3 ? ((const float*)b3)[j] : bf2f(((const bf16*)b3)[j]);
            args.out[i] = s0 * 1e9f; args.out[R + i] = s1 * 1e6f; args.out[2 * R + i] = s2 * 1e3f; args.out[3 * R + i] = s3;
        }
    }
#endif
#undef IN
#undef BOTH
}

extern "C" void kernel_launch(void* const* d_in, const int* in_sizes, int n_in, void* d_out, int out_size, void* d_ws, size_t ws_size, hipStream_t stream) {
    static int grid = 0;
    if (grid == 0) {
        if (n_in != 26 || in_sizes[0] != M * D || out_size != M * D || ws_size < WS_END) { fprintf(stderr, "kernel_launch: built for 26 inputs, x/out of %d floats, >= %zu bytes of workspace; got n_in %d, in0 %d, out %d, ws %zu; nothing launched\n", M * D, (size_t)WS_END, n_in, n_in > 0 ? in_sizes[0] : -1, out_size, ws_size); grid = -1; return; }
        int dev = 0, cus = 0, per_cu = 0;
        if (hipGetDevice(&dev) != hipSuccess || hipDeviceGetAttribute(&cus, hipDeviceAttributeMultiprocessorCount, dev) != hipSuccess) { fprintf(stderr, "kernel_launch: hipGetDevice / hipDeviceGetAttribute failed\n"); grid = -1; return; }
        if (hipFuncSetAttribute((const void*)hyb_fwd, hipFuncAttributeMaxDynamicSharedMemorySize, LDS_BYTES) != hipSuccess) { fprintf(stderr, "kernel_launch: hipFuncSetAttribute failed\n"); grid = -1; return; }
        if (hipOccupancyMaxActiveBlocksPerMultiprocessor(&per_cu, (const void*)hyb_fwd, NWAVES * 64, LDS_BYTES) != hipSuccess || per_cu < 1)
            fprintf(stderr, "kernel_launch: note: the occupancy query reports %d workgroups per CU\n", per_cu);
        (void)hipGetLastError();
        grid = cus;
    }
    if (grid < 0) return;
    if (hipMemsetAsync((char*)d_ws + WS_CTL, 0, CTL_ZERO_BYTES, stream) != hipSuccess) { fprintf(stderr, "kernel_launch: hipMemsetAsync failed\n"); return; }
    Args a{};
    const float** ap = (const float**)&a;
    for (int i = 0; i < 26; ++i) ap[i] = (const float*)d_in[i];
    a.out = (float*)d_out; a.ws = (unsigned char*)d_ws;
#if defined(DBG_STOP)
    const int nl = DBG_STOP + 2;
#else
    const int nl = N_LAUNCHES;
#endif
    for (int li = 0; li < nl; ++li) {
        a.ph_lo = (N_LAUNCHES == 1) ? 0 : li; a.ph_hi = (N_LAUNCHES == 1) ? NPH : li + 1;
#if defined(DBG_STOP)
        if (li == nl - 1) { a.ph_lo = NPH; a.ph_hi = NPH + 1; }
#endif
        hipLaunchKernelGGL(hyb_fwd, dim3(grid), dim3(NWAVES * 64), LDS_BYTES, stream, a);
        const hipError_t le = hipPeekAtLastError();
        if (le != hipSuccess) { fprintf(stderr, "kernel_launch: launch %d failed: %s\n", li, hipGetErrorName(le)); break; }
    }
#if defined(PROBE_PHASE)
    a.ph_lo = PROBE_PHASE; a.ph_hi = PROBE_PHASE + 1; a.sub = PROBE_SUB;
    hipLaunchKernelGGL(hyb_fwd, dim3(grid), dim3(NWAVES * 64), LDS_BYTES, stream, a);
#endif
}
```
